# Optimizing an MI355X kernel written in HIP

```python
import math
import jax, jax.numpy as jnp
from jax import lax
import numpy as np

D_MODEL = 1024
BATCH = 16
SEQ = 4096
DEPTH = 1

HEAD_DIM = 64
D_MIX = D_MODEL
A_HEADS = D_MIX // 2 // HEAD_DIM
A_KV = A_HEADS // 4
B_HEADS = D_MIX // 2 // HEAD_DIM
B_KV = B_HEADS // 4
D_A = A_HEADS * HEAD_DIM
D_B = B_HEADS * HEAD_DIM
KV_A = A_KV * HEAD_DIM
KV_B = B_KV * HEAD_DIM
N_HEADS_TOTAL = A_HEADS + B_HEADS
SWA_WINDOW = 128
ATTN_BLOCK = 128
CMP_LEN = 32
CMP_STRIDE = 16
CMP_HIDDEN = 256
SEL_LEN = 64
SEL_TOPK = 16
NSA_WINDOW = 512
NSA_Q_CHUNK = 32
N_NSA_BRANCHES = 3
N_BUCKETS = 32
MAX_DISTANCE = 128
FORCE_BONUS = 1e4
EPS = 1e-6
PROJ_SIZES = (D_A, KV_A, KV_A, D_A,
              D_B, KV_B, KV_B, KV_B, KV_B, KV_B, KV_B, D_B, B_HEADS * N_NSA_BRANCHES)
D_PROJ = sum(PROJ_SIZES)

kernel_name = "hybrid_swa_sink_nsa_adaln_block"


def _split_points():
    pts, acc = [], 0
    for s in PROJ_SIZES[:-1]:
        acc += s
        pts.append(acc)
    return pts


def rms_norm(x, gain):
    xf = x.astype(jnp.float32)
    y = xf * lax.rsqrt(jnp.mean(xf * xf, -1, keepdims=True) + EPS)
    return (y * gain.astype(jnp.float32)).astype(x.dtype)


def qk_norm(t, gain):
    tf = t.astype(jnp.float32)
    return tf * lax.rsqrt(jnp.mean(tf * tf, -1, keepdims=True) + EPS) * gain.astype(jnp.float32)


def t5_bucket(dist):
    n = jnp.maximum(dist, 0)
    max_exact = N_BUCKETS // 2
    nf = jnp.maximum(n, 1).astype(jnp.float32)
    large = max_exact + (jnp.log(nf / max_exact) / math.log(MAX_DISTANCE / max_exact)
                         * (N_BUCKETS - max_exact)).astype(jnp.int32)
    large = jnp.minimum(large, N_BUCKETS - 1)
    return jnp.where(n < max_exact, n, large)


def masked_softmax(logits, mask, sink=None):
    z = jnp.where(mask, logits, -jnp.inf)
    m = jnp.max(z, -1, keepdims=True)
    if sink is not None:
        m = jnp.maximum(m, sink)
    m = jnp.where(jnp.isfinite(m), m, 0.0)
    e = jnp.where(mask, jnp.exp(z - m), 0.0)
    denom = jnp.sum(e, -1, keepdims=True)
    if sink is not None:
        denom = denom + jnp.exp(sink - m)
    return e / jnp.maximum(denom, 1e-30)


def banded_gqa(q, k, v, window, head_bias, sinks):
    Bn, S, H, D = q.shape
    G = k.shape[2]
    R = H // G
    nblk = S // ATTN_BLOCK
    span = window + ATTN_BLOCK
    kp = jnp.pad(k.astype(jnp.float32), ((0, 0), (window, 0), (0, 0), (0, 0)))
    vp = jnp.pad(v.astype(jnp.float32), ((0, 0), (window, 0), (0, 0), (0, 0)))
    qb = q.reshape(Bn, nblk, ATTN_BLOCK, G, R, D).transpose(1, 0, 2, 3, 4, 5)
    hb = head_bias.astype(jnp.float32)
    sink = None if sinks is None else sinks.astype(jnp.float32).reshape(G, R, 1, 1)
    q_off = jnp.arange(ATTN_BLOCK)
    k_off = jnp.arange(span)

    def block(args):
        qi, i = args
        start = i * ATTN_BLOCK
        kb = lax.dynamic_slice_in_dim(kp, start, span, axis=1)
        vb = lax.dynamic_slice_in_dim(vp, start, span, axis=1)
        t = start + q_off
        s = start - window + k_off
        dist = t[:, None] - s[None, :]
        mask = (dist >= 0) & (dist < window) & (s[None, :] >= 0)
        bias = hb[t5_bucket(dist)].reshape(ATTN_BLOCK, span, G, R).transpose(2, 3, 0, 1)
        logits = jnp.einsum('btgrd,bsgd->bgrts', qi, kb) + bias
        p = masked_softmax(logits, mask, sink)
        return jnp.einsum('bgrts,bsgd->btgrd', p, vb)

    out = lax.map(block, (qb, jnp.arange(nblk)))
    return out.transpose(1, 0, 2, 3, 4, 5).reshape(Bn, S, H, D)


def compress_blocks(t, pos, w1, w2):
    Bn, S, G, D = t.shape
    nc = (S - CMP_LEN) // CMP_STRIDE + 1
    idx = jnp.arange(nc)[:, None] * CMP_STRIDE + jnp.arange(CMP_LEN)[None, :]
    blocks = t[:, idx] + pos[None, None, :, None, :]
    flat = blocks.transpose(0, 1, 3, 2, 4).reshape(Bn, nc, G, CMP_LEN * D)
    return jax.nn.silu(flat @ w1) @ w2


def nsa_cmp_sel(q, k_cmp, v_cmp, k_sel, v_sel, head_bias):
    Bn, S, H, D = q.shape
    G = k_sel.shape[2]
    R = H // G
    nc = k_cmp.shape[1]
    ns = S // SEL_LEN
    topk = min(SEL_TOPK, ns)
    qc_len = NSA_Q_CHUNK
    nch = S // qc_len
    kc = k_cmp.astype(jnp.float32)
    vc = v_cmp.astype(jnp.float32)
    ks_b = k_sel.astype(jnp.float32).reshape(Bn, ns, SEL_LEN, G, D).transpose(0, 3, 1, 2, 4)
    vs_b = v_sel.astype(jnp.float32).reshape(Bn, ns, SEL_LEN, G, D).transpose(0, 3, 1, 2, 4)
    c_lo = jnp.arange(nc) * CMP_STRIDE
    c_end = c_lo + CMP_LEN - 1
    s_lo = jnp.arange(ns) * SEL_LEN
    overlap = jnp.clip(jnp.minimum(c_lo[:, None] + CMP_LEN, s_lo[None, :] + SEL_LEN)
                       - jnp.maximum(c_lo[:, None], s_lo[None, :]), 0, None).astype(jnp.float32) / CMP_LEN
    tbl = head_bias.astype(jnp.float32).reshape(N_BUCKETS, G, R).transpose(1, 0, 2)
    g_idx = jnp.arange(G)[None, :, None, None]
    blk = jnp.arange(ns)
    gather = jax.vmap(jax.vmap(lambda kb, ix: kb[ix]))
    qch = q.reshape(Bn, nch, qc_len, G, R, D).transpose(1, 0, 2, 3, 4, 5)

    def chunk(args):
        qi, i = args
        t = i * qc_len + jnp.arange(qc_len)
        logits_c = jnp.einsum('btgrd,bngd->bgrtn', qi, kc)
        p_c = masked_softmax(logits_c, c_end[None, :] <= t[:, None])
        o_cmp = jnp.einsum('bgrtn,bngd->btgrd', p_c, vc)
        imp = jnp.einsum('bgrtn,nj->bgtj', p_c, overlap)
        cur = t // SEL_LEN
        valid = blk[None, :] <= cur[:, None]
        forced = (blk[None, :] == 0) | (blk[None, :] == cur[:, None]) | (blk[None, :] == cur[:, None] - 1)
        score = jnp.where(valid, imp + jnp.where(forced, FORCE_BONUS, 0.0), -jnp.inf)
        _, sel = lax.top_k(score, topk)
        kg = gather(ks_b, sel).reshape(Bn, G, qc_len, topk * SEL_LEN, D)
        vg = gather(vs_b, sel).reshape(Bn, G, qc_len, topk * SEL_LEN, D)
        spos = (sel[..., None] * SEL_LEN + jnp.arange(SEL_LEN)).reshape(Bn, G, qc_len, topk * SEL_LEN)
        dist = t[None, None, :, None] - spos
        bias = tbl[g_idx, t5_bucket(dist)].transpose(0, 1, 4, 2, 3)
        logits_s = jnp.einsum('btgrd,bgtld->bgrtl', qi, kg) + bias
        p_s = masked_softmax(logits_s, (dist >= 0)[:, :, None])
        o_sel = jnp.einsum('bgrtl,bgtld->btgrd', p_s, vg)
        return o_cmp, o_sel

    o_cmp, o_sel = lax.map(chunk, (qch, jnp.arange(nch)))
    o_cmp = o_cmp.transpose(1, 0, 2, 3, 4, 5).reshape(Bn, S, H, D)
    o_sel = o_sel.transpose(1, 0, 2, 3, 4, 5).reshape(Bn, S, H, D)
    return o_cmp, o_sel


def hybrid_layer(x, c, w_ada, b_ada, norm_gain, w_in, b_nsa_gate, q_gain_a, k_gain_a, sinks,
                 q_gain_b, k_gain_cmp, k_gain_sel, k_gain_win, cmp_pos_k, cmp_pos_v,
                 w_cmp_k1, w_cmp_k2, w_cmp_v1, w_cmp_v2, w_out, rel_bias):
    Bn, S, _ = x.shape
    qscale = HEAD_DIM ** -0.5
    mod = jax.nn.silu(c) @ w_ada + b_ada
    shift, scale, gate = jnp.split(mod, 3, axis=-1)
    h = rms_norm(x, norm_gain) * (1 + scale[:, None, :]) + shift[:, None, :]
    proj = h @ w_in
    (q_a, k_a, v_a, z_a, q_b, kc, vc, ks, vs, kw, vw, z_b, g_b) = jnp.split(proj, _split_points(), axis=-1)
    heads = lambda t, n: t.reshape(Bn, S, n, HEAD_DIM)

    qa = qk_norm(heads(q_a, A_HEADS), q_gain_a) * qscale
    ka = qk_norm(heads(k_a, A_KV), k_gain_a)
    o_a = banded_gqa(qa, ka, heads(v_a, A_KV), SWA_WINDOW, rel_bias[:, :A_HEADS], sinks)

    bias_b = rel_bias[:, A_HEADS:]
    qb = qk_norm(heads(q_b, B_HEADS), q_gain_b) * qscale
    k_cmp = qk_norm(compress_blocks(heads(kc, B_KV), cmp_pos_k, w_cmp_k1, w_cmp_k2), k_gain_cmp)
    v_cmp = compress_blocks(heads(vc, B_KV), cmp_pos_v, w_cmp_v1, w_cmp_v2)
    k_sel = qk_norm(heads(ks, B_KV), k_gain_sel)
    k_win = qk_norm(heads(kw, B_KV), k_gain_win)
    o_cmp, o_sel = nsa_cmp_sel(qb, k_cmp, v_cmp, k_sel, heads(vs, B_KV), bias_b)
    o_win = banded_gqa(qb, k_win, heads(vw, B_KV), NSA_WINDOW, bias_b, None)
    gb = jax.nn.sigmoid((g_b + b_nsa_gate).astype(jnp.float32)).reshape(Bn, S, B_HEADS, N_NSA_BRANCHES, 1)
    o_b = gb[..., 0, :] * o_cmp + gb[..., 1, :] * o_sel + gb[..., 2, :] * o_win

    y = jnp.concatenate([o_a.reshape(Bn, S, D_A) * jax.nn.silu(z_a.astype(jnp.float32)),
                         o_b.reshape(Bn, S, D_B) * jax.nn.silu(z_b.astype(jnp.float32))], axis=-1)
    out = y.astype(x.dtype) @ w_out
    return x + gate[:, None, :] * out


def setup_inputs(seed: int = 0) -> dict:
    key = jax.random.key(seed)
    ks = jax.random.split(key, 24)
    nrm = lambda k, shape, s: jax.random.normal(k, shape, jnp.float32) * s
    gain = lambda k, shape: 1.0 + 0.1 * jax.random.normal(k, shape, jnp.float32)
    L = DEPTH
    return {
        "x": nrm(ks[0], (BATCH, SEQ, D_MODEL), 1.0),
        "c": nrm(ks[1], (BATCH, D_MODEL), 1.0),
        "w_ada": nrm(ks[2], (L, D_MODEL, 3 * D_MODEL), 0.5 * D_MODEL ** -0.5),
        "b_ada": nrm(ks[3], (L, 3 * D_MODEL), 0.01),
        "norm_gain": gain(ks[4], (L, D_MODEL)),
        "w_in": nrm(ks[5], (L, D_MODEL, D_PROJ), D_MODEL ** -0.5),
        "b_nsa_gate": nrm(ks[6], (L, B_HEADS * N_NSA_BRANCHES), 0.1),
        "q_gain_a": gain(ks[7], (L, HEAD_DIM)),
        "k_gain_a": gain(ks[8], (L, HEAD_DIM)),
        "sinks": nrm(ks[9], (L, A_HEADS), 1.0),
        "q_gain_b": gain(ks[10], (L, HEAD_DIM)),
        "k_gain_cmp": gain(ks[11], (L, HEAD_DIM)),
        "k_gain_sel": gain(ks[12], (L, HEAD_DIM)),
        "k_gain_win": gain(ks[13], (L, HEAD_DIM)),
        "cmp_pos_k": nrm(ks[14], (L, CMP_LEN, HEAD_DIM), 0.5),
        "cmp_pos_v": nrm(ks[15], (L, CMP_LEN, HEAD_DIM), 0.5),
        "w_cmp_k1": nrm(ks[16], (L, CMP_LEN * HEAD_DIM, CMP_HIDDEN), (CMP_LEN * HEAD_DIM) ** -0.5),
        "w_cmp_k2": nrm(ks[17], (L, CMP_HIDDEN, HEAD_DIM), CMP_HIDDEN ** -0.5),
        "w_cmp_v1": nrm(ks[18], (L, CMP_LEN * HEAD_DIM, CMP_HIDDEN), (CMP_LEN * HEAD_DIM) ** -0.5),
        "w_cmp_v2": nrm(ks[19], (L, CMP_HIDDEN, HEAD_DIM), CMP_HIDDEN ** -0.5),
        "w_out": nrm(ks[20], (L, D_MIX, D_MODEL), D_MIX ** -0.5),
        "rel_bias": nrm(ks[21], (N_BUCKETS, N_HEADS_TOTAL), 0.5),
    }


def reference(x, c, w_ada, b_ada, norm_gain, w_in, b_nsa_gate, q_gain_a, k_gain_a, sinks,
              q_gain_b, k_gain_cmp, k_gain_sel, k_gain_win, cmp_pos_k, cmp_pos_v,
              w_cmp_k1, w_cmp_k2, w_cmp_v1, w_cmp_v2, w_out, rel_bias):
    for l in range(DEPTH):
        x = hybrid_layer(x, c, w_ada[l], b_ada[l], norm_gain[l], w_in[l], b_nsa_gate[l],
                         q_gain_a[l], k_gain_a[l], sinks[l], q_gain_b[l], k_gain_cmp[l],
                         k_gain_sel[l], k_gain_win[l], cmp_pos_k[l], cmp_pos_v[l],
                         w_cmp_k1[l], w_cmp_k2[l], w_cmp_v1[l], w_cmp_v2[l], w_out[l], rel_bias)
    return x
```

```cpp
#include <hip/hip_runtime.h>
#include <hip/hip_cooperative_groups.h>
#include <cstdio>
#include <cstdint>
namespace cg = cooperative_groups;

#ifndef N_LAUNCHES
#define N_LAUNCHES 5
#endif
#ifndef EN_A
#define EN_A 1
#endif
#ifndef EN_CMP
#define EN_CMP 1
#endif
#ifndef EN_SEL
#define EN_SEL 1
#endif
#ifndef EN_WIN
#define EN_WIN 1
#endif

#define DI __device__ __forceinline__
typedef unsigned short bf16_t;
typedef short bf16x8 __attribute__((ext_vector_type(8)));
typedef float f32x2 __attribute__((ext_vector_type(2)));
typedef float f32x4 __attribute__((ext_vector_type(4)));
typedef float f32x16 __attribute__((ext_vector_type(16)));
typedef unsigned u32x2 __attribute__((ext_vector_type(2)));
typedef unsigned u32x4 __attribute__((ext_vector_type(4)));
typedef __bf16 bf16x2v __attribute__((ext_vector_type(2)));

constexpr int NBATCH = 16, SEQ = 4096, M = NBATCH * SEQ, DM = 1024, NPROJ = 3096, NPADW = 3200;
constexpr float EPS = 1e-6f, LOG2E = 1.4426950408889634f;
constexpr size_t MiB = 1u << 20;
constexpr size_t WS_CTL = 0;
constexpr size_t WS_MOD = 1 * MiB;
constexpr size_t WS_BIAS1 = WS_MOD + 256 * 1024;
constexpr size_t WS_W2T = 2 * MiB;
constexpr size_t WS_W1T = 3 * MiB;
constexpr size_t WS_WOUTT = 5 * MiB;
constexpr size_t WS_WINT = 7 * MiB;
constexpr size_t WS_KCMP = 14 * MiB;
constexpr size_t WS_VCMPT = 15 * MiB;
constexpr size_t WS_GB = 16 * MiB;
constexpr size_t WS_H = 32 * MiB;
constexpr size_t WS_Y = 160 * MiB;
constexpr size_t WS_HM = 288 * MiB;
constexpr size_t WS_END = WS_HM + (size_t)48 * M * 64 * 2;
constexpr int LDS_BYTES = 73728;

struct Params {
    const float *x, *c, *w_ada, *b_ada, *norm_gain, *w_in, *b_gate, *q_gain_a, *k_gain_a, *sinks, *q_gain_b,
        *k_gain_cmp, *k_gain_sel, *k_gain_win, *cmp_pos_k, *cmp_pos_v, *w_cmp_k1, *w_cmp_k2, *w_cmp_v1, *w_cmp_v2, *w_out, *rel_bias;
    float* out; unsigned char* ws; int ph_lo, ph_hi;
};

DI unsigned pk2(float lo, float hi) { f32x2 v = {lo, hi}; bf16x2v b = __builtin_convertvector(v, bf16x2v); return __builtin_bit_cast(unsigned, b); }
DI float bflo(unsigned u) { return __builtin_bit_cast(float, u << 16); }
DI float bfhi(unsigned u) { return __builtin_bit_cast(float, u & 0xffff0000u); }
DI float ex2(float x) { return __builtin_amdgcn_exp2f(x); }
DI float rsq(float x) { return __builtin_amdgcn_rsqf(x); }
DI float sigm(float x) { return 1.f / (1.f + __expf(-x)); }
DI float wave_sum(float v) {
#pragma unroll
    for (int o = 1; o < 64; o <<= 1) v += __shfl_xor(v, o);
    return v;
}
DI f32x4 mfma16(bf16x8 a, bf16x8 b, f32x4 c) { return __builtin_amdgcn_mfma_f32_16x16x32_bf16(a, b, c, 0, 0, 0); }
DI f32x16 mfma32(bf16x8 a, bf16x8 b, f32x16 c) { return __builtin_amdgcn_mfma_f32_32x32x16_bf16(a, b, c, 0, 0, 0); }
DI int t5_bucket(int n) {
    if (n < 16) return n < 0 ? 0 : n;
    int b = 16;
    b += (n >= 19); b += (n >= 21); b += (n >= 24); b += (n >= 27); b += (n >= 31); b += (n >= 35); b += (n >= 40); b += (n >= 46);
    b += (n >= 52); b += (n >= 59); b += (n >= 67); b += (n >= 77); b += (n >= 87); b += (n >= 99); b += (n >= 113);
    return b;
}

DI void p0_mod_item(const Params& p, int item, char* lds, float* mod) {
    const int tid = threadIdx.x, col = tid & 15, kg = tid >> 4, n0 = item * 16;
    float acc[16];
#pragma unroll
    for (int b = 0; b < 16; ++b) acc[b] = 0.f;
    for (int kk = 0; kk < 64; ++kk) {
        const int k = kg * 64 + kk;
        const float w = p.w_ada[(size_t)k * 3072 + n0 + col];
#pragma unroll
        for (int b = 0; b < 16; ++b) { const float cv = p.c[b * 1024 + k]; acc[b] += cv * sigm(cv) * w; }
    }
    float* red = (float*)lds;
#pragma unroll
    for (int b = 0; b < 16; ++b) red[(kg * 16 + b) * 16 + col] = acc[b];
    __syncthreads();
    { const int b = tid >> 4; float s = 0.f;
#pragma unroll
      for (int g = 0; g < 16; ++g) s += red[(g * 16 + b) * 16 + col];
      mod[b * 3072 + n0 + col] = s + p.b_ada[n0 + col]; }
    __syncthreads();
}
DI void p0_transpose_item(const float* src, int K, int N, bf16_t* dst, int kb, int nb, char* lds) {
    const int tid = threadIdx.x; float* t = (float*)lds;
    const int k0 = kb * 64, n0 = nb * 64;
#pragma unroll 4
    for (int i = 0; i < 16; ++i) { const int r = i * 4 + (tid >> 6), cc = tid & 63;
        t[r * 65 + cc] = (n0 + cc < N) ? src[(size_t)(k0 + r) * N + n0 + cc] : 0.f; }
    __syncthreads();
    { const int n = tid >> 2, kc = (tid & 3) * 16;
      u32x4 o0, o1;
      o0.x = pk2(t[(kc + 0) * 65 + n], t[(kc + 1) * 65 + n]); o0.y = pk2(t[(kc + 2) * 65 + n], t[(kc + 3) * 65 + n]);
      o0.z = pk2(t[(kc + 4) * 65 + n], t[(kc + 5) * 65 + n]); o0.w = pk2(t[(kc + 6) * 65 + n], t[(kc + 7) * 65 + n]);
      o1.x = pk2(t[(kc + 8) * 65 + n], t[(kc + 9) * 65 + n]); o1.y = pk2(t[(kc + 10) * 65 + n], t[(kc + 11) * 65 + n]);
      o1.z = pk2(t[(kc + 12) * 65 + n], t[(kc + 13) * 65 + n]); o1.w = pk2(t[(kc + 14) * 65 + n], t[(kc + 15) * 65 + n]);
      u32x4* d = (u32x4*)(dst + (size_t)(n0 + n) * K + k0 + kc); d[0] = o0; d[1] = o1; }
    __syncthreads();
}
DI void p0_bias1_item(const Params& p, int item, char* lds, float* bias1) {
    const int tid = threadIdx.x, kv = item >> 2, n0 = (item & 3) * 64, col = tid & 63, kg = tid >> 6;
    const float* pos = kv ? p.cmp_pos_v : p.cmp_pos_k; const float* w1 = kv ? p.w_cmp_v1 : p.w_cmp_k1;
    float a = 0.f;
    for (int kk = 0; kk < 512; ++kk) { const int k = kg * 512 + kk; a += pos[k] * w1[(size_t)k * 256 + n0 + col]; }
    float* red = (float*)lds; red[kg * 64 + col] = a;
    __syncthreads();
    if (tid < 64) bias1[kv * 256 + n0 + tid] = (red[tid] + red[64 + tid]) + (red[128 + tid] + red[192 + tid]);
    __syncthreads();
}
DI void phase0(const Params& p, char* lds) {
    float* mod = (float*)(p.ws + WS_MOD); float* bias1 = (float*)(p.ws + WS_BIAS1);
    bf16_t* WinT = (bf16_t*)(p.ws + WS_WINT); bf16_t* WoutT = (bf16_t*)(p.ws + WS_WOUTT);
    bf16_t* W1T = (bf16_t*)(p.ws + WS_W1T); bf16_t* W2T = (bf16_t*)(p.ws + WS_W2T);
    constexpr int I_MOD = 192, I_B1 = 8, I_WIN = 16 * 50, I_WOUT = 16 * 16, I_W1 = 32 * 4, I_W2 = 4;
    constexpr int NITEMS = I_MOD + I_B1 + I_WIN + I_WOUT + 2 * I_W1 + 2 * I_W2;
    for (int it = blockIdx.x; it < NITEMS; it += gridDim.x) {
        int r = it;
        if (r < I_MOD) { p0_mod_item(p, r, lds, mod); continue; } r -= I_MOD;
        if (r < I_B1) { p0_bias1_item(p, r, lds, bias1); continue; } r -= I_B1;
        if (r < I_WIN) { p0_transpose_item(p.w_in, 1024, NPROJ, WinT, r / 50, r % 50, lds); continue; } r -= I_WIN;
        if (r < I_WOUT) { p0_transpose_item(p.w_out, 1024, 1024, WoutT, r / 16, r % 16, lds); continue; } r -= I_WOUT;
        if (r < I_W1) { p0_transpose_item(p.w_cmp_k1, 2048, 256, W1T, r / 4, r % 4, lds); continue; } r -= I_W1;
        if (r < I_W1) { p0_transpose_item(p.w_cmp_v1, 2048, 256, W1T + 256 * 2048, r / 4, r % 4, lds); continue; } r -= I_W1;
        if (r < I_W2) { p0_transpose_item(p.w_cmp_k2, 256, 64, W2T, r, 0, lds); continue; } r -= I_W2;
        p0_transpose_item(p.w_cmp_v2, 256, 64, W2T + 64 * 256, r, 0, lds);
    }
}

template <bool TRANS>
DI void gemm_tile_128(const bf16_t* __restrict__ Wt, const bf16_t* __restrict__ X, int K, int ldw, int ldx, char* lds, f32x4 (&acc)[4][4]) {
    const int tid = threadIdx.x, lane = tid & 63, wid = tid >> 6, wn = wid & 1, wm = wid >> 1;
    const int srow = tid >> 3, sch = tid & 7;
    const bf16_t* wp = Wt + (size_t)srow * ldw + sch * 8;
    const bf16_t* xp = X + (size_t)srow * ldx + sch * 8;
    const int sofs = srow * 128 + ((sch ^ ((srow >> 1) & 7)) << 4);
    u32x4 wr[4], xr[4];
#pragma unroll
    for (int i = 0; i < 4; ++i)
#pragma unroll
        for (int j = 0; j < 4; ++j) acc[i][j] = (f32x4){0.f, 0.f, 0.f, 0.f};
#pragma unroll
    for (int q = 0; q < 4; ++q) { wr[q] = *(const u32x4*)(wp + (size_t)q * 32 * ldw); xr[q] = *(const u32x4*)(xp + (size_t)q * 32 * ldx); }
#pragma unroll
    for (int q = 0; q < 4; ++q) { *(u32x4*)(lds + sofs + q * 4096) = wr[q]; *(u32x4*)(lds + 16384 + sofs + q * 4096) = xr[q]; }
    __syncthreads();
    const int nk = K >> 6;
    const int fro = (lane & 15) * 128, fsw = (lane >> 1) & 7, fq = lane >> 4;
    for (int kt = 0; kt < nk; ++kt) {
        const bool more = kt + 1 < nk;
        if (more) {
#pragma unroll
            for (int q = 0; q < 4; ++q) { wr[q] = *(const u32x4*)(wp + (size_t)q * 32 * ldw + (kt + 1) * 64); xr[q] = *(const u32x4*)(xp + (size_t)q * 32 * ldx + (kt + 1) * 64); }
        }
        const char* sW = lds + (kt & 1) * 32768; const char* sX = sW + 16384;
#pragma unroll
        for (int ks = 0; ks < 2; ++ks) {
            bf16x8 wf[4], xf[4];
            const int co = ((ks * 4 + fq) ^ fsw) << 4;
#pragma unroll
            for (int i = 0; i < 4; ++i) { wf[i] = *(const bf16x8*)(sW + (wn * 64 + i * 16) * 128 + fro + co); xf[i] = *(const bf16x8*)(sX + (wm * 64 + i * 16) * 128 + fro + co); }
#pragma unroll
            for (int ni = 0; ni < 4; ++ni)
#pragma unroll
                for (int mi = 0; mi < 4; ++mi) {
                    if (TRANS) acc[ni][mi] = mfma16(wf[ni], xf[mi], acc[ni][mi]);
                    else acc[mi][ni] = mfma16(xf[mi], wf[ni], acc[mi][ni]);
                }
        }
        if (more) {
            char* d = lds + ((kt + 1) & 1) * 32768;
#pragma unroll
            for (int q = 0; q < 4; ++q) { *(u32x4*)(d + sofs + q * 4096) = wr[q]; *(u32x4*)(d + 16384 + sofs + q * 4096) = xr[q]; }
        }
        __syncthreads();
    }
}

DI void p1_norm_tile(const Params& p, int m0, bf16_t* H, const float* mod) {
    const int tid = threadIdx.x, lane = tid & 63, wid = tid >> 6, b = m0 >> 12;
    const float* shift = mod + b * 3072; const float* scale = shift + 1024;
    f32x4 ca[4], cb[4];
#pragma unroll
    for (int j = 0; j < 4; ++j) { const int k = j * 256 + lane * 4;
        const f32x4 g = *(const f32x4*)(p.norm_gain + k), sc = *(const f32x4*)(scale + k); cb[j] = *(const f32x4*)(shift + k);
        ca[j] = g * (sc + 1.f); }
#pragma unroll 2
    for (int r = 0; r < 32; ++r) {
        const int m = m0 + wid * 32 + r;
        const f32x4* xr = (const f32x4*)(p.x + (size_t)m * 1024) + lane;
        f32x4 v[4]; float ss = 0.f;
#pragma unroll
        for (int j = 0; j < 4; ++j) { v[j] = xr[64 * j]; ss += (v[j].x * v[j].x + v[j].y * v[j].y) + (v[j].z * v[j].z + v[j].w * v[j].w); }
        ss = wave_sum(ss);
        const float rstd = rsq(ss * (1.f / 1024.f) + EPS);
        u32x2* o = (u32x2*)(H + (size_t)m * 1024) + lane;
#pragma unroll
        for (int j = 0; j < 4; ++j) { const f32x4 hv = v[j] * rstd * ca[j] + cb[j]; u32x2 w; w.x = pk2(hv.x, hv.y); w.y = pk2(hv.z, hv.w); o[64 * j] = w; }
    }
}
DI void p1_store4(bf16_t* dst, f32x4 v) { u32x2 w; w.x = pk2(v.x, v.y); w.y = pk2(v.z, v.w); *(u32x2*)dst = w; }
DI void p1_epilogue_trans(const Params& p, int nt, int m0, f32x4 (&acc)[4][4], bf16_t* HM, float* GB) {
    const int tid = threadIdx.x, lane = tid & 63, wid = tid >> 6, wn = wid & 1, wm = wid >> 1;
    const int mrow = m0 + wm * 64 + (lane & 15), dq = (lane >> 4) * 4;
    if (nt == 24) {
        if (wn == 0) {
#pragma unroll
            for (int ni = 0; ni < 2; ++ni) { const int n = ni * 16 + dq;
                if (n < 24) { const f32x4 bg = *(const f32x4*)(p.b_gate + n);
#pragma unroll
                    for (int mi = 0; mi < 4; ++mi) { const f32x4 a = acc[ni][mi] + bg; f32x4 o; o.x = sigm(a.x); o.y = sigm(a.y); o.z = sigm(a.z); o.w = sigm(a.w);
                        *(f32x4*)(GB + (size_t)(mrow + mi * 16) * 24 + n) = o; } } }
        }
        return;
    }
    const int slot = nt * 2 + wn;
    bf16_t* base = HM + ((size_t)slot * M + mrow) * 64 + dq;
    const float* gain = nullptr; float extra = 1.f; int kind = 0;
    if (slot < 8) { gain = p.q_gain_a; extra = 0.125f * LOG2E; kind = 1; }
    else if (slot < 10) { gain = p.k_gain_a; kind = 1; }
    else if (slot < 20) kind = 2;
    else if (slot < 28) { gain = p.q_gain_b; extra = 0.125f * LOG2E; kind = 1; }
    else if (slot < 32) kind = 0;
    else if (slot < 34) { gain = p.k_gain_sel; kind = 1; }
    else if (slot < 38) { gain = p.k_gain_win; kind = 1; }
    else kind = 2;
    if (kind == 1) {
        f32x4 gv[4];
#pragma unroll
        for (int ni = 0; ni < 4; ++ni) gv[ni] = *(const f32x4*)(gain + ni * 16 + dq);
#pragma unroll
        for (int mi = 0; mi < 4; ++mi) {
            float ss = 0.f;
#pragma unroll
            for (int ni = 0; ni < 4; ++ni) { const f32x4 a = acc[ni][mi]; ss += (a.x * a.x + a.y * a.y) + (a.z * a.z + a.w * a.w); }
            ss += __shfl_xor(ss, 16); ss += __shfl_xor(ss, 32);
            const float rs = rsq(ss * (1.f / 64.f) + EPS) * extra;
#pragma unroll
            for (int ni = 0; ni < 4; ++ni) p1_store4(base + (size_t)mi * 16 * 64 + ni * 16, acc[ni][mi] * rs * gv[ni]);
        }
    } else if (kind == 2) {
#pragma unroll
        for (int mi = 0; mi < 4; ++mi)
#pragma unroll
            for (int ni = 0; ni < 4; ++ni) { const f32x4 a = acc[ni][mi]; f32x4 o; o.x = a.x * sigm(a.x); o.y = a.y * sigm(a.y); o.z = a.z * sigm(a.z); o.w = a.w * sigm(a.w);
                p1_store4(base + (size_t)mi * 16 * 64 + ni * 16, o); }
    } else {
#pragma unroll
        for (int mi = 0; mi < 4; ++mi)
#pragma unroll
            for (int ni = 0; ni < 4; ++ni) p1_store4(base + (size_t)mi * 16 * 64 + ni * 16, acc[ni][mi]);
    }
}
DI void p1_epilogue_vt(int nt, int m0, f32x4 (&acc)[4][4], bf16_t* HM) {
    const int tid = threadIdx.x, lane = tid & 63, wid = tid >> 6, wn = wid & 1, wm = wid >> 1;
    const int slot = nt * 2 + wn;
    bf16_t* base = HM + (size_t)slot * M * 64 + (size_t)((m0 >> 6) + wm) * 4096 + (lane >> 4) * 4;
#pragma unroll
    for (int mi = 0; mi < 4; ++mi)
#pragma unroll
        for (int ni = 0; ni < 4; ++ni) p1_store4(base + (ni * 16 + (lane & 15)) * 64 + mi * 16, acc[mi][ni]);
}
DI void phase1(const Params& p, char* lds) {
    bf16_t* H = (bf16_t*)(p.ws + WS_H); bf16_t* HM = (bf16_t*)(p.ws + WS_HM); float* GB = (float*)(p.ws + WS_GB);
    const float* mod = (const float*)(p.ws + WS_MOD); const bf16_t* WinT = (const bf16_t*)(p.ws + WS_WINT);
    for (int tile = blockIdx.x; tile < M / 128; tile += gridDim.x) {
        const int m0 = tile * 128;
        p1_norm_tile(p, m0, H, mod);
        __threadfence_block();
        __syncthreads();
        for (int nt = 0; nt < 25; ++nt) {
            f32x4 acc[4][4];
            if (nt == 5 || nt == 17 || nt == 19) {
                gemm_tile_128<false>(WinT + (size_t)nt * 128 * 1024, H + (size_t)m0 * 1024, 1024, 1024, 1024, lds, acc);
                p1_epilogue_vt(nt, m0, acc, HM);
            } else {
                gemm_tile_128<true>(WinT + (size_t)nt * 128 * 1024, H + (size_t)m0 * 1024, 1024, 1024, 1024, lds, acc);
                p1_epilogue_trans(p, nt, m0, acc, HM, GB);
            }
        }
    }
}

DI void p2_item(const Params& p, int item, char* lds) {
    const int tid = threadIdx.x, lane = tid & 63, w = tid >> 6;
    const int kv = item & 1, ct = (item >> 1) & 7, bg = item >> 4, b = bg >> 1, g = bg & 1;
    const bf16_t* HM = (const bf16_t*)(p.ws + WS_HM);
    const int slot = (kv ? 30 : 28) + g;
    const bf16_t* Xbase = HM + ((size_t)slot * M + (size_t)b * 4096) * 64;
    const bf16_t* W1 = (const bf16_t*)(p.ws + WS_W1T) + (size_t)kv * 256 * 2048;
    const bf16_t* W2 = (const bf16_t*)(p.ws + WS_W2T) + (size_t)kv * 64 * 256;
    const float* bias1 = (const float*)(p.ws + WS_BIAS1) + kv * 256;
    const int srow = tid >> 3, sch = tid & 7;
    const int sofs = srow * 128 + ((sch ^ ((srow >> 1) & 7)) << 4);
    int cx = ct * 32 + srow; if (cx > 254) cx = 254;
    const bf16_t* xp = Xbase + (size_t)cx * 1024 + sch * 8;
    const bf16_t* wp = W1 + (size_t)srow * 2048 + sch * 8;
    constexpr int STG = 36864;
    u32x4 wr[8], xr;
    f32x4 acc[4][2];
#pragma unroll
    for (int i = 0; i < 4; ++i) { acc[i][0] = (f32x4){0.f, 0.f, 0.f, 0.f}; acc[i][1] = (f32x4){0.f, 0.f, 0.f, 0.f}; }
#pragma unroll
    for (int q = 0; q < 8; ++q) wr[q] = *(const u32x4*)(wp + (size_t)q * 32 * 2048);
    xr = *(const u32x4*)xp;
#pragma unroll
    for (int q = 0; q < 8; ++q) *(u32x4*)(lds + sofs + q * 4096) = wr[q];
    *(u32x4*)(lds + 32768 + sofs) = xr;
    __syncthreads();
    const int fro = (lane & 15) * 128, fsw = (lane >> 1) & 7, fq = lane >> 4;
    for (int kt = 0; kt < 32; ++kt) {
        const bool more = kt < 31;
        if (more) {
#pragma unroll
            for (int q = 0; q < 8; ++q) wr[q] = *(const u32x4*)(wp + (size_t)q * 32 * 2048 + (kt + 1) * 64);
            xr = *(const u32x4*)(xp + (kt + 1) * 64);
        }
        const char* sW = lds + (kt & 1) * STG; const char* sX = sW + 32768;
#pragma unroll
        for (int ks = 0; ks < 2; ++ks) {
            const int co = ((ks * 4 + fq) ^ fsw) << 4;
            bf16x8 wf[4], xf[2];
#pragma unroll
            for (int i = 0; i < 4; ++i) wf[i] = *(const bf16x8*)(sW + (w * 64 + i * 16) * 128 + fro + co);
#pragma unroll
            for (int i = 0; i < 2; ++i) xf[i] = *(const bf16x8*)(sX + (i * 16) * 128 + fro + co);
#pragma unroll
            for (int ni = 0; ni < 4; ++ni)
#pragma unroll
                for (int mi = 0; mi < 2; ++mi) acc[ni][mi] = mfma16(wf[ni], xf[mi], acc[ni][mi]);
        }
        if (more) {
            char* d = lds + ((kt + 1) & 1) * STG;
#pragma unroll
            for (int q = 0; q < 8; ++q) *(u32x4*)(d + sofs + q * 4096) = wr[q];
            *(u32x4*)(d + 32768 + sofs) = xr;
        }
        __syncthreads();
    }
    char* Hs = lds;
    float* Os = (float*)(lds + 16384);
    {
        const int dq = (lane >> 4) * 4;
#pragma unroll
        for (int ni = 0; ni < 4; ++ni) { const int n = w * 64 + ni * 16 + dq; const f32x4 bv = *(const f32x4*)(bias1 + n);
#pragma unroll
            for (int mi = 0; mi < 2; ++mi) { const int m = mi * 16 + (lane & 15); const f32x4 a = acc[ni][mi] + bv;
                u32x2 o; o.x = pk2(a.x * sigm(a.x), a.y * sigm(a.y)); o.y = pk2(a.z * sigm(a.z), a.w * sigm(a.w));
                *(u32x2*)(Hs + m * 512 + (((n >> 3) ^ (m & 15)) << 4) + ((n >> 2) & 1) * 8) = o; } }
    }
    __syncthreads();
    {
        f32x4 a2[2] = {(f32x4){0.f, 0.f, 0.f, 0.f}, (f32x4){0.f, 0.f, 0.f, 0.f}};
        const bf16_t* w2p = W2 + (size_t)(w * 16 + (lane & 15)) * 256 + fq * 8;
#pragma unroll
        for (int ks = 0; ks < 8; ++ks) {
            const bf16x8 wf = *(const bf16x8*)(w2p + ks * 32);
#pragma unroll
            for (int mi = 0; mi < 2; ++mi) { const int m = mi * 16 + (lane & 15);
                const bf16x8 xf = *(const bf16x8*)(Hs + m * 512 + (((ks * 4 + fq) ^ (m & 15)) << 4));
                a2[mi] = mfma16(wf, xf, a2[mi]); }
        }
#pragma unroll
        for (int mi = 0; mi < 2; ++mi) *(f32x4*)(Os + (mi * 16 + (lane & 15)) * 68 + w * 16 + fq * 4) = a2[mi];
    }
    __syncthreads();
    if (kv == 0) {
        const int m = tid >> 3, d0 = (tid & 7) * 8;
        const f32x4 v0 = *(const f32x4*)(Os + m * 68 + d0), v1 = *(const f32x4*)(Os + m * 68 + d0 + 4);
        float ss = (v0.x * v0.x + v0.y * v0.y) + (v0.z * v0.z + v0.w * v0.w) + (v1.x * v1.x + v1.y * v1.y) + (v1.z * v1.z + v1.w * v1.w);
        ss += __shfl_xor(ss, 1); ss += __shfl_xor(ss, 2); ss += __shfl_xor(ss, 4);
        const float rs = rsq(ss * (1.f / 64.f) + EPS);
        const f32x4 g0 = *(const f32x4*)(p.k_gain_cmp + d0), g1 = *(const f32x4*)(p.k_gain_cmp + d0 + 4);
        const f32x4 a = v0 * rs * g0, c = v1 * rs * g1;
        u32x4 o; o.x = pk2(a.x, a.y); o.y = pk2(a.z, a.w); o.z = pk2(c.x, c.y); o.w = pk2(c.z, c.w);
        *(u32x4*)((bf16_t*)(p.ws + WS_KCMP) + ((size_t)bg * 256 + ct * 32 + m) * 64 + d0) = o;
    } else {
        const int d = tid >> 2, c0 = (tid & 3) * 8;
        u32x4 o;
        o.x = pk2(Os[(c0 + 0) * 68 + d], Os[(c0 + 1) * 68 + d]); o.y = pk2(Os[(c0 + 2) * 68 + d], Os[(c0 + 3) * 68 + d]);
        o.z = pk2(Os[(c0 + 4) * 68 + d], Os[(c0 + 5) * 68 + d]); o.w = pk2(Os[(c0 + 6) * 68 + d], Os[(c0 + 7) * 68 + d]);
        *(u32x4*)((bf16_t*)(p.ws + WS_VCMPT) + ((size_t)bg * 64 + d) * 256 + ct * 32 + c0) = o;
    }
    __syncthreads();
}
DI void phase2(const Params& p, char* lds) {
    for (int it = blockIdx.x; it < 512; it += gridDim.x) p2_item(p, it, lds);
}

constexpr int L3_WSCR = 32768;
constexpr int L3_TBL0 = 32768 + 4 * 8448;
constexpr int L3_TBL1 = L3_TBL0 + 2112;
constexpr int L3_SC = L3_TBL0 + 4224;
constexpr int L3_UNIT = L3_SC + 64;
static_assert(L3_UNIT + 16 <= 73728, "P3 LDS map");
struct WB { int hi_min, hi_max, lo_min, lo_max; };

DI void subtile_pv(const char* Kt, const char* Vt, int sub, int kidx0, int tq, int lane, const bf16x8 (&qf)[4], f32x16 (&O)[2], float& lsum,
                   const float* tbl, float cadd, int hi_t, int lo_t, bool need_mask, bool use_tbl) {
    const int kr = lane & 31, h = lane >> 5;
    f32x16 s;
#pragma unroll
    for (int i = 0; i < 16; ++i) s[i] = 0.f;
    { const int row = sub * 32 + kr; const char* kp = Kt + row * 128; const int sw = (row >> 1) & 7;
#pragma unroll
      for (int ks = 0; ks < 4; ++ks) { const bf16x8 kf = *(const bf16x8*)(kp + (((2 * ks + h) ^ sw) << 4)); s = mfma32(kf, qf[ks], s); } }
    float e[16];
    if (use_tbl) {
#pragma unroll
        for (int r = 0; r < 16; ++r) { const int kidx = kidx0 + (r & 3) + 8 * (r >> 2) + 4 * h;
            int dist = tq - kidx; dist = dist < 0 ? 0 : (dist > 128 ? 128 : dist); s[r] += tbl[dist]; }
    }
#pragma unroll
    for (int r = 0; r < 16; ++r) {
        const int kidx = kidx0 + (r & 3) + 8 * (r >> 2) + 4 * h;
        float a = s[r] + cadd;
        if (need_mask) a = (kidx <= hi_t && kidx >= lo_t) ? a : -INFINITY;
        e[r] = ex2(a);
        lsum += e[r];
    }
    bf16x8 pf[2];
#pragma unroll
    for (int s2 = 0; s2 < 2; ++s2) { u32x4 pp; pp.x = pk2(e[8 * s2 + 0], e[8 * s2 + 1]); pp.y = pk2(e[8 * s2 + 2], e[8 * s2 + 3]);
        pp.z = pk2(e[8 * s2 + 4], e[8 * s2 + 5]); pp.w = pk2(e[8 * s2 + 6], e[8 * s2 + 7]); pf[s2] = __builtin_bit_cast(bf16x8, pp); }
#pragma unroll
    for (int db = 0; db < 2; ++db) {
        const int d = db * 32 + kr, x = (d >> 1) & 15; const char* vp = Vt + d * 128;
#pragma unroll
        for (int s2 = 0; s2 < 2; ++s2) {
            const int sl = sub * 8 + s2 * 4 + h;
            const u32x2 v0 = *(const u32x2*)(vp + ((sl ^ x) << 3)), v1 = *(const u32x2*)(vp + (((sl + 2) ^ x) << 3));
            u32x4 vv; vv.x = v0.x; vv.y = v0.y; vv.z = v1.x; vv.w = v1.y;
            O[db] = mfma32(__builtin_bit_cast(bf16x8, vv), pf[s2], O[db]);
        }
    }
}

DI void stage_load(const bf16_t* Kt, const bf16_t* Vt, int v_ld, u32x4 (&kr)[2], u32x4 (&vr)[2]) {
    const int tid = threadIdx.x;
#pragma unroll
    for (int i = 0; i < 2; ++i) { const int idx = tid + 256 * i; kr[i] = *(const u32x4*)(Kt + idx * 8);
        vr[i] = *(const u32x4*)(Vt + (size_t)(idx >> 3) * v_ld + (idx & 7) * 8); }
}
DI void stage_store(char* st, const u32x4 (&kr)[2], const u32x4 (&vr)[2]) {
    const int tid = threadIdx.x;
#pragma unroll
    for (int i = 0; i < 2; ++i) { const int idx = tid + 256 * i, row = idx >> 3, ch = idx & 7;
        *(u32x4*)(st + row * 128 + ((ch ^ ((row >> 1) & 7)) << 4)) = kr[i];
        const int x = (row >> 1) & 15; char* vp = st + 8192 + row * 128;
        u32x2 a, b; a.x = vr[i].x; a.y = vr[i].y; b.x = vr[i].z; b.y = vr[i].w;
        *(u32x2*)(vp + (((2 * ch) ^ x) << 3)) = a; *(u32x2*)(vp + (((2 * ch + 1) ^ x) << 3)) = b; }
}

DI void attn_pass(const bf16_t* Kbase, const bf16_t* Vbase, int v_tile_stride, int v_ld, int tlo, int thi, char* lds,
                  int tq0, int lane, const bf16x8 (&qf)[4], f32x16 (&O)[2], float& lsum, const float* tbl, float cfar, bool bias, bool sel,
                  int hi_t, int lo_t, const WB& wb, unsigned mask_even, unsigned mask_odd) {
    const int n = thi - tlo + 1;
    if (n <= 0) return;
    const int tq = tq0 + (lane & 31);
    u32x4 kr[2], vr[2];
    stage_load(Kbase + (size_t)tlo * 4096, Vbase + (size_t)tlo * v_tile_stride, v_ld, kr, vr);
    stage_store(lds, kr, vr);
    __syncthreads();
    for (int i = 0; i < n; ++i) {
        const int tile = tlo + i; const bool more = i + 1 < n;
        if (more) stage_load(Kbase + (size_t)(tile + 1) * 4096, Vbase + (size_t)(tile + 1) * v_tile_stride, v_ld, kr, vr);
        const char* st = lds + (i & 1) * 16384;
        float selterm = 0.f; bool any = true;
        if (sel) { const unsigned mk = (tile & 1) ? mask_odd : mask_even; const bool bit = (mk >> (tile >> 1)) & 1u;
            selterm = bit ? 0.f : -INFINITY; any = __ballot(bit) != 0ull; }
        if (any) {
#pragma unroll 1
            for (int sub = 0; sub < 2; ++sub) {
                const int k0 = tile * 64 + sub * 32;
                if (k0 > wb.hi_max || k0 + 31 < wb.lo_min) continue;
                const bool need_mask = (k0 + 31 > wb.hi_min) || (k0 < wb.lo_max);
                const bool use_tbl = bias && (tq0 - (k0 + 31) < 128);
                subtile_pv(st, st + 8192, sub, k0, tq, lane, qf, O, lsum, tbl, (use_tbl ? 0.f : cfar) + selterm, hi_t, lo_t, need_mask, use_tbl);
            }
        }
        if (more) stage_store(lds + ((i + 1) & 1) * 16384, kr, vr);
        __syncthreads();
    }
}

DI void load_q(const bf16_t* HM, int slot, int m, int lane, bf16x8 (&qf)[4]) {
    const bf16_t* q = HM + ((size_t)slot * M + m) * 64 + (lane >> 5) * 8;
#pragma unroll
    for (int ks = 0; ks < 4; ++ks) qf[ks] = *(const bf16x8*)(q + ks * 16);
}
DI void write_y(bf16_t* Y, const bf16_t* HM, int zslot, int m, int col0, int lane, const f32x16 (&yc)[2]) {
    const int h = lane >> 5;
    const bf16_t* z = HM + ((size_t)zslot * M + m) * 64; bf16_t* y = Y + (size_t)m * 1024 + col0;
#pragma unroll
    for (int db = 0; db < 2; ++db)
#pragma unroll
        for (int rg = 0; rg < 4; ++rg) { const int d = db * 32 + 8 * rg + 4 * h;
            const u32x2 zz = *(const u32x2*)(z + d);
            u32x2 o; o.x = pk2(yc[db][4 * rg + 0] * bflo(zz.x), yc[db][4 * rg + 1] * bfhi(zz.x));
            o.y = pk2(yc[db][4 * rg + 2] * bflo(zz.y), yc[db][4 * rg + 3] * bfhi(zz.y));
            *(u32x2*)(y + d) = o; }
}
DI void build_table(const Params& p, float* tbl, float* sc, const float* gq, const float* gk, int head0) {
    const int tid = threadIdx.x;
    float gm = 0.f;
    for (int d = 0; d < 64; ++d) gm = fmaxf(gm, fabsf(gq[d] * gk[d]));
    for (int i = tid; i < 4 * 129; i += 256) { const int r = i / 129, dist = i % 129;
        float bm = 0.f;
        for (int bk = 0; bk < 32; ++bk) bm = fmaxf(bm, p.rel_bias[bk * 16 + head0 + r]);
        const float shift = 8.f * gm + bm;
        tbl[r * 132 + dist] = (p.rel_bias[t5_bucket(dist) * 16 + head0 + r] - shift) * LOG2E;
        if (dist == 0) sc[r] = shift; }
}

DI f32x16 cmp_qk(const char* lds, int st, int lane, const bf16x8 (&qf)[4]) {
    f32x16 s;
#pragma unroll
    for (int i = 0; i < 16; ++i) s[i] = 0.f;
    const int row = st * 32 + (lane & 31), h = lane >> 5; const char* kp = lds + row * 128; const int sw = (row >> 1) & 7;
#pragma unroll
    for (int ks = 0; ks < 4; ++ks) { const bf16x8 kf = *(const bf16x8*)(kp + (((2 * ks + h) ^ sw) << 4)); s = mfma32(kf, qf[ks], s); }
    return s;
}
DI void unit(const Params& p, bool isB, int bg, int qb, char* lds) {
    const int tid = threadIdx.x, lane = tid & 63, w = tid >> 6, b = bg >> 1, g = bg & 1, h = lane >> 5;
    const bf16_t* HM = (const bf16_t*)(p.ws + WS_HM); bf16_t* Y = (bf16_t*)(p.ws + WS_Y); const float* GB = (const float*)(p.ws + WS_GB);
    float* tbl0 = (float*)(lds + L3_TBL0); float* tbl1 = (float*)(lds + L3_TBL1); float* sc = (float*)(lds + L3_SC);
    float* wsc = (float*)(lds + L3_WSCR + w * 8448) + lane;
    const int t0 = qb * 128, tq0 = t0 + 32 * w, tq = tq0 + (lane & 31), m = b * 4096 + tq;
    const int thi = (t0 + 127) >> 6;
    const bf16_t* Kc = (const bf16_t*)(p.ws + WS_KCMP) + (size_t)bg * 256 * 64;
    const bf16_t* Vc = (const bf16_t*)(p.ws + WS_VCMPT) + (size_t)bg * 64 * 256;
    const int hic_t = (tq - 31) >> 4;
    const int ctmax = ((t0 + 96) >> 4) >> 6;
    float ccmp = 0.f;
    unsigned mask_even = 0xffffffffu, mask_odd = 0xffffffffu;
    if (!isB) {
        build_table(p, tbl0, sc, p.q_gain_a, p.k_gain_a, 4 * g);
        __syncthreads();
    } else {
        build_table(p, tbl0, sc, p.q_gain_b, p.k_gain_sel, 8 + 4 * g);
        build_table(p, tbl1, sc + 4, p.q_gain_b, p.k_gain_win, 8 + 4 * g);
        { float gm = 0.f; for (int d = 0; d < 64; ++d) gm = fmaxf(gm, fabsf(p.q_gain_b[d] * p.k_gain_cmp[d])); ccmp = -8.f * gm * LOG2E; }
        const int nst = ((tq0 >> 4) >> 5) + 1;
        for (int i = tid; i < (ctmax + 1) * 512; i += 256) { const int row = i >> 3, ch = i & 7;
            *(u32x4*)(lds + row * 128 + ((ch ^ ((row >> 1) & 7)) << 4)) = *(const u32x4*)(Kc + (size_t)i * 8); }
        for (int i = 0; i < 33; ++i) wsc[i * 64] = 0.f;
        __syncthreads();
#pragma unroll 1
        for (int r = 0; r < 4; ++r) {
            bf16x8 qf[4]; load_q(HM, 20 + 4 * g + r, m, lane, qf);
            float lsum = 0.f;
#pragma unroll 1
            for (int st = 0; st < nst; ++st) {
                const f32x16 s = cmp_qk(lds, st, lane, qf);
#pragma unroll
                for (int i = 0; i < 16; ++i) { const int kidx = st * 32 + (i & 3) + 8 * (i >> 2) + 4 * h; float a = s[i] + ccmp; a = (kidx <= hic_t) ? a : -INFINITY; lsum += ex2(a); }
            }
            const float l = lsum + __shfl_xor(lsum, 32);
            const float inv = l > 0.f ? 1.f / l : 0.f;
#pragma unroll 1
            for (int st = 0; st < nst; ++st) {
                const f32x16 s = cmp_qk(lds, st, lane, qf);
#pragma unroll
                for (int q = 0; q < 4; ++q) {
                    float e[4];
#pragma unroll
                    for (int j = 0; j < 4; ++j) { const int kidx = st * 32 + j + 8 * q + 4 * h; float a = s[4 * q + j] + ccmp; a = (kidx <= hic_t) ? a : -INFINITY; e[j] = ex2(a) * inv; }
                    const float half = 0.5f * e[3];
                    const float recv = __shfl_xor(half, 32);
                    float* ip = wsc + (st * 4 + q) * 64;
                    ip[0] += (e[0] + e[1]) + (e[2] + half) + (h ? recv : 0.f);
                    ip[64] += (h ? 0.f : recv);
                }
            }
        }
        const int cur = tq0 >> 6;
        if (cur >= 16) {
            unsigned* keyL = (unsigned*)wsc;
#pragma unroll 4
            for (int i = 0; i < 32; ++i) { const int j = 2 * i + h; const bool ok = (j >= 1) && (j <= cur - 2);
                const unsigned bits = __builtin_bit_cast(unsigned, wsc[i * 64]);
                keyL[i * 64] = ok ? ((bits & 0xffffffc0u) + 64u + (unsigned)(63 - j)) : 0u; }
            mask_even = 1u; mask_odd = 0u;
            if (cur & 1) { mask_odd |= 1u << (cur >> 1); mask_even |= 1u << ((cur - 1) >> 1); }
            else { mask_even |= 1u << (cur >> 1); mask_odd |= 1u << ((cur - 1) >> 1); }
#pragma unroll 1
            for (int it = 0; it < 13; ++it) {
                unsigned mx = 0u;
#pragma unroll 8
                for (int i = 0; i < 32; ++i) { const unsigned k = keyL[i * 64]; mx = mx > k ? mx : k; }
                const unsigned mo = (unsigned)__shfl_xor((int)mx, 32); mx = mx > mo ? mx : mo;
                const int j = 63 - (int)(mx & 63u);
                if ((j & 1) == h) keyL[(j >> 1) * 64] = 0u;
                if (j & 1) mask_odd |= 1u << (j >> 1); else mask_even |= 1u << (j >> 1);
            }
        }
        __syncthreads();
    }
    const int nbr = isB ? 3 : 1;
    bf16x8 qf[4];
#pragma unroll 1
    for (int it = 0; it < 4 * nbr; ++it) {
        const int r = isB ? it / 3 : it, br = isB ? it - 3 * r : 0;
        const int mode = isB ? br + 1 : 0;
        if (br == 0) load_q(HM, (isB ? 20 : 0) + 4 * g + r, m, lane, qf);
        const bf16_t *Kb, *Vb; int vts = 4096, vld = 64, tlo = 0, th = thi, hi_t = tq, lo_t = 0; bool bias = true, sel = false;
        const float* tbl = tbl0 + r * 132; float cfar; WB wb; wb.hi_min = tq0; wb.hi_max = tq0 + 31; wb.lo_min = 0; wb.lo_max = 0;
        float gate = 1.f;
        if (mode == 0) {
            Kb = HM + ((size_t)(8 + g) * M + (size_t)b * 4096) * 64; Vb = HM + ((size_t)(10 + g) * M + (size_t)b * 4096) * 64;
            tlo = (t0 - 128) < 0 ? 0 : ((t0 - 128) >> 6); lo_t = tq - 127; wb.lo_min = tq0 - 127; wb.lo_max = tq0 + 31 - 127;
        } else if (mode == 1) {
            Kb = Kc; Vb = Vc; vts = 64; vld = 256; th = ctmax; hi_t = hic_t; bias = false;
            wb.hi_min = (tq0 - 31) >> 4; wb.hi_max = tq0 >> 4;
        } else if (mode == 2) {
            Kb = HM + ((size_t)(32 + g) * M + (size_t)b * 4096) * 64; Vb = HM + ((size_t)(34 + g) * M + (size_t)b * 4096) * 64; sel = true;
        } else {
            Kb = HM + ((size_t)(36 + g) * M + (size_t)b * 4096) * 64; Vb = HM + ((size_t)(38 + g) * M + (size_t)b * 4096) * 64; tbl = tbl1 + r * 132;
            tlo = (t0 - 512) < 0 ? 0 : ((t0 - 512) >> 6); lo_t = tq - 511; wb.lo_min = tq0 - 511; wb.lo_max = tq0 + 31 - 511;
        }
        cfar = (mode == 1) ? ccmp : tbl[128];
        if (isB) gate = GB[(size_t)m * 24 + (4 * g + r) * 3 + br];
        f32x16 O[2];
#pragma unroll
        for (int i = 0; i < 16; ++i) { O[0][i] = 0.f; O[1][i] = 0.f; }
        float lsum = 0.f;
        attn_pass(Kb, Vb, vts, vld, tlo, th, lds, tq0, lane, qf, O, lsum, tbl, cfar, bias, sel, hi_t, lo_t, wb, mask_even, mask_odd);
        float l = lsum + __shfl_xor(lsum, 32);
        if (mode == 0) l += ex2((p.sinks[4 * g + r] - sc[r]) * LOG2E);
        float sc_ = (l > 0.f ? 1.f / l : 0.f) * gate;
        if ((mode == 0 && !EN_A) || (mode == 1 && !EN_CMP) || (mode == 2 && !EN_SEL) || (mode == 3 && !EN_WIN)) sc_ = 0.f;
        if (br == 0) {
#pragma unroll
            for (int i = 0; i < 16; ++i) { wsc[i * 64] = O[0][i] * sc_; wsc[(16 + i) * 64] = O[1][i] * sc_; }
        } else {
#pragma unroll
            for (int i = 0; i < 16; ++i) { wsc[i * 64] += O[0][i] * sc_; wsc[(16 + i) * 64] += O[1][i] * sc_; }
        }
        if (br == nbr - 1) {
#pragma unroll
            for (int i = 0; i < 16; ++i) { O[0][i] = wsc[i * 64]; O[1][i] = wsc[(16 + i) * 64]; }
            write_y(Y, HM, (isB ? 40 : 12) + 4 * g + r, m, (isB ? 512 : 0) + (4 * g + r) * 64, lane, O);
        }
    }
    __syncthreads();
}

DI void phase3(const Params& p, char* lds) {
    unsigned* ctr = (unsigned*)(p.ws + WS_CTL);
    volatile int* su = (volatile int*)(lds + L3_UNIT);
    for (;;) {
        if (threadIdx.x == 0) *su = (int)atomicAdd(ctr, 1u);
        __syncthreads();
        const int u = *su;
        __syncthreads();
        if (u >= 2048) break;
        const bool isB = u < 1024; const int uu = isB ? u : u - 1024;
        unit(p, isB, uu & 31, 31 - (uu >> 5), lds);
    }
}

DI void phase4(const Params& p, char* lds) {
    const bf16_t* Y = (const bf16_t*)(p.ws + WS_Y); const bf16_t* WoutT = (const bf16_t*)(p.ws + WS_WOUTT);
    const float* mod = (const float*)(p.ws + WS_MOD);
    const int tid = threadIdx.x, lane = tid & 63, wid = tid >> 6, wn = wid & 1, wm = wid >> 1;
    for (int tile = blockIdx.x; tile < M / 128; tile += gridDim.x) {
        const int m0 = tile * 128, b = m0 >> 12;
        const float* gate = mod + b * 3072 + 2048;
        for (int nt = 0; nt < 8; ++nt) {
            f32x4 acc[4][4];
            gemm_tile_128<true>(WoutT + (size_t)nt * 128 * 1024, Y + (size_t)m0 * 1024, 1024, 1024, 1024, lds, acc);
#pragma unroll
            for (int mi = 0; mi < 4; ++mi) { const size_t mrow = (size_t)(m0 + wm * 64 + mi * 16 + (lane & 15)) * 1024;
#pragma unroll
                for (int ni = 0; ni < 4; ++ni) { const int n = nt * 128 + wn * 64 + ni * 16 + (lane >> 4) * 4;
                    const f32x4 xv = *(const f32x4*)(p.x + mrow + n), gv = *(const f32x4*)(gate + n);
                    *(f32x4*)(p.out + mrow + n) = xv + gv * acc[ni][mi]; } }
        }
    }
}

__global__ void __launch_bounds__(256, 2) fwd_kernel(Params p) {
    extern __shared__ __attribute__((aligned(16))) char lds[];
    cg::grid_group grid = cg::this_grid();
    const int lo = p.ph_lo, hi = p.ph_hi;
#ifdef ONLY_PHASE
#define IN(k) ((k)==ONLY_PHASE && lo <= (k) && (k) < hi)
#else
#define IN(k) (lo <= (k) && (k) < hi)
#endif
    if (IN(0)) { phase0(p, lds); if (IN(1)) grid.sync(); }
    if (IN(1)) { phase1(p, lds); if (IN(2)) grid.sync(); }
    if (IN(2)) { phase2(p, lds); if (IN(3)) grid.sync(); }
    if (IN(3)) { phase3(p, lds); if (IN(4)) grid.sync(); }
    if (IN(4)) { phase4(p, lds); }
#undef IN
}

extern "C" void kernel_launch(void* const* d_in, const int* in_sizes, int n_in, void* d_out, int out_size, void* d_ws, size_t ws_size, hipStream_t stream) {
    static int grid = 0;
    if (grid == 0) {
        if (n_in != 22 || out_size != M * DM || ws_size < WS_END) { fprintf(stderr, "kernel_launch: unexpected shapes (n_in %d out %d ws %zu need %zu)\n", n_in, out_size, ws_size, (size_t)WS_END); grid = -1; return; }
        int dev = 0, cus = 0, per_cu = 0;
        hipGetDevice(&dev); hipDeviceGetAttribute(&cus, hipDeviceAttributeMultiprocessorCount, dev);
        hipFuncSetAttribute((const void*)fwd_kernel, hipFuncAttributeMaxDynamicSharedMemorySize, LDS_BYTES);
        hipOccupancyMaxActiveBlocksPerMultiprocessor(&per_cu, (const void*)fwd_kernel, 256, LDS_BYTES);
        if (per_cu < 1) { fprintf(stderr, "kernel_launch: occupancy query says %d blocks/CU\n", per_cu); per_cu = 1; }
        if (per_cu > 2) per_cu = 2;
        grid = cus * per_cu;
        fprintf(stderr, "kernel_launch: cus %d per_cu %d grid %d\n", cus, per_cu, grid);
    }
    if (grid < 0) return;
    hipMemsetAsync((char*)d_ws + WS_CTL, 0, 4096, stream);
    Params p{};
    const float** pin = (const float**)&p;
    for (int i = 0; i < 22; ++i) pin[i] = (const float*)d_in[i];
    p.out = (float*)d_out; p.ws = (unsigned char*)d_ws;
#if N_LAUNCHES == 1
    p.ph_lo = 0; p.ph_hi = 5;
    void* args[] = {&p};
    hipError_t e = hipLaunchCooperativeKernel((const void*)fwd_kernel, dim3(grid), dim3(256), args, LDS_BYTES, stream);
    if (e != hipSuccess) fprintf(stderr, "cooperative launch failed: %s (grid %d)\n", hipGetErrorString(e), grid);
#else
    for (int ph = 0; ph < 5; ++ph) { p.ph_lo = ph; p.ph_hi = ph + 1; hipLaunchKernelGGL(fwd_kernel, dim3(grid), dim3(256), LDS_BYTES, stream, p); }
#endif
}
```

```cpp
#include <hip/hip_runtime.h>
#include <cstdio>
#include <cstdint>

#ifndef GEMM_ALIGN
#define GEMM_ALIGN true
#endif
#ifndef GEMM_SP2
#define GEMM_SP2 true
#endif
#ifndef N_LAUNCHES
#define N_LAUNCHES 1
#endif

#define DI __device__ __forceinline__
#define LAS __attribute__((address_space(3)))
typedef unsigned short bf16_t;
typedef short bf16x8 __attribute__((ext_vector_type(8)));
typedef short s16x4 __attribute__((ext_vector_type(4)));
typedef float f32x2 __attribute__((ext_vector_type(2)));
typedef float f32x4 __attribute__((ext_vector_type(4)));
typedef float f32x16 __attribute__((ext_vector_type(16)));
typedef unsigned u32x2 __attribute__((ext_vector_type(2)));
typedef unsigned u32x4 __attribute__((ext_vector_type(4)));
typedef __bf16 bf16x2v __attribute__((ext_vector_type(2)));

constexpr int NBATCH = 16, SEQ = 4096, M = NBATCH * SEQ, DM = 1024, NPROJ = 3096, NPADW = 3072;
constexpr float EPS = 1e-6f, LOG2E = 1.4426950408889634f;
constexpr size_t MiB = 1u << 20;
constexpr size_t WS_CTL = 0;
constexpr size_t CTL_BYTES = 32768;
constexpr size_t WS_MOD = 1 * MiB;
constexpr size_t WS_BIAS1 = WS_MOD + 256 * 1024;
constexpr size_t WS_TBL = WS_MOD + 512 * 1024;
constexpr size_t WS_W2T = 2 * MiB;
constexpr size_t WS_W1T = 3 * MiB;
constexpr size_t WS_WOUTT = 5 * MiB;
constexpr size_t WS_WINT = 7 * MiB;
constexpr size_t WS_KCMP = 14 * MiB;
constexpr size_t WS_VCMP = 15 * MiB;
constexpr size_t WS_GB = 16 * MiB;
constexpr size_t WS_H = 32 * MiB;
constexpr size_t WS_Y = 160 * MiB;
constexpr size_t WS_HM = 288 * MiB;
constexpr size_t WS_END = WS_HM + (size_t)48 * M * 64 * 2;
constexpr int LDS_BYTES = 148992;
constexpr int LDS_MISC = 148480;
constexpr int NTHREADS = 512;

struct Params {
    const float *x, *c, *w_ada, *b_ada, *norm_gain, *w_in, *b_gate, *q_gain_a, *k_gain_a, *sinks, *q_gain_b,
        *k_gain_cmp, *k_gain_sel, *k_gain_win, *cmp_pos_k, *cmp_pos_v, *w_cmp_k1, *w_cmp_k2, *w_cmp_v1, *w_cmp_v2, *w_out, *rel_bias;
    float* out; unsigned char* ws; int ph_lo, ph_hi;
};

DI unsigned pk2(float lo, float hi) { f32x2 v = {lo, hi}; bf16x2v b = __builtin_convertvector(v, bf16x2v); return __builtin_bit_cast(unsigned, b); }
DI float bflo(unsigned u) { return __builtin_bit_cast(float, u << 16); }
DI float bfhi(unsigned u) { return __builtin_bit_cast(float, u & 0xffff0000u); }
DI float ex2(float x) { return __builtin_amdgcn_exp2f(x); }
DI float rsq(float x) { return __builtin_amdgcn_rsqf(x); }
DI float sigm(float x) { return __builtin_amdgcn_rcpf(1.f + __builtin_amdgcn_exp2f(x * -LOG2E)); }
DI float wave_sum(float v) {
#pragma unroll
    for (int o = 1; o < 64; o <<= 1) v += __shfl_xor(v, o);
    return v;
}
DI f32x4 mfma16(bf16x8 a, bf16x8 b, f32x4 c) { return __builtin_amdgcn_mfma_f32_16x16x32_bf16(a, b, c, 0, 0, 0); }
DI f32x16 mfma32(bf16x8 a, bf16x8 b, f32x16 c) { return __builtin_amdgcn_mfma_f32_32x32x16_bf16(a, b, c, 0, 0, 0); }
DI int t5_bucket(int n) {
    if (n < 16) return n < 0 ? 0 : n;
    int b = 16;
    b += (n >= 19); b += (n >= 21); b += (n >= 24); b += (n >= 27); b += (n >= 31); b += (n >= 35); b += (n >= 40); b += (n >= 46);
    b += (n >= 52); b += (n >= 59); b += (n >= 67); b += (n >= 77); b += (n >= 87); b += (n >= 99); b += (n >= 113);
    return b;
}

#define XB_TMO      128
#define XB_XCNT(j)  (256  + 64 * (j))
#define XB_XSUB(j)  (1280 + 64 * (j))
#define XB_XGEN(j)  (2304 + 64 * (j))
#define XB_TOP      3328
#define XB_TOPGEN   3392
#define XCD_BAR_WORDS 3456
#define XB_SPIN_CAP (1u << 18)
DI unsigned xb_ld(unsigned* p)              { return __hip_atomic_load(p, __ATOMIC_RELAXED, __HIP_MEMORY_SCOPE_AGENT); }
DI unsigned xb_add(unsigned* p, unsigned v) { return __hip_atomic_fetch_add(p, v, __ATOMIC_RELAXED, __HIP_MEMORY_SCOPE_AGENT); }
DI unsigned xb_xcc_id() { return (unsigned)__builtin_amdgcn_s_getreg((3 << 11) | 20) & 0xFu; }
#define XB_SPIN(cond, bar) do { unsigned _sp = 0; while (cond) { __builtin_amdgcn_s_sleep(1); \
    if ((++_sp & 255u) == 0u) { if (xb_ld(&(bar)[XB_TMO])) break; if (_sp > XB_SPIN_CAP) { atomicAdd(&(bar)[XB_TMO], 1u); break; } } } } while (0)
struct XcdBarrier { unsigned* bar; unsigned x; volatile LAS unsigned* st; };
DI XcdBarrier xcd_barrier_post(unsigned* bar, volatile LAS unsigned* st) {
    XcdBarrier b; b.bar = bar; b.x = xb_xcc_id(); b.st = st;
    if (threadIdx.x == 0) (void)xb_add(&bar[XB_XCNT(b.x)], 1u);
    return b;
}
DI void xcd_barrier_complete(unsigned* bar, unsigned x, unsigned& nloc, unsigned& nx) {
    const unsigned G = gridDim.x * gridDim.y * gridDim.z;
    unsigned sum, cnt, mine, sp = 0u;
    for (;;) {
        sum = 0u; cnt = 0u; mine = 0u;
#pragma unroll
        for (unsigned j = 0; j < 16; ++j) { const unsigned c = xb_ld(&bar[XB_XCNT(j)]); sum += c; cnt += (c > 0u) ? 1u : 0u; mine = (j == x) ? c : mine; }
        if (sum == G) break;
        __builtin_amdgcn_s_sleep(1);
        if ((++sp & 255u) == 0u) { if (xb_ld(&bar[XB_TMO])) break; if (sp > XB_SPIN_CAP) { atomicAdd(&bar[XB_TMO], 1u); break; } }
    }
    nloc = mine > 0u ? mine : 1u; nx = cnt > 0u ? cnt : 1u;
}
DI void xcd_barrier(const XcdBarrier& b) {
    asm volatile("s_waitcnt vmcnt(0)" ::: "memory");
    __syncthreads();
    if (threadIdx.x == 0) {
        unsigned* bar = b.bar;
        __builtin_amdgcn_s_waitcnt(0);
        unsigned nloc = b.st[0], nx = b.st[1];
        if (nloc == 0u) { xcd_barrier_complete(bar, b.x, nloc, nx); b.st[0] = nloc; b.st[1] = nx; }
        const unsigned old = xb_add(&bar[XB_XSUB(b.x)], 1u);
        const unsigned gen = old / nloc;
        if (old + 1u == (gen + 1u) * nloc) {
            __builtin_amdgcn_fence(__ATOMIC_RELEASE, "agent");
            asm volatile("s_waitcnt vmcnt(0)" ::: "memory");
            const unsigned og = xb_add(&bar[XB_TOP], 1u);
            const unsigned tg = og / nx;
            if (og + 1u == (tg + 1u) * nx) xb_add(&bar[XB_TOPGEN], 1u);
            else XB_SPIN(xb_ld(&bar[XB_TOPGEN]) == tg, bar);
            __builtin_amdgcn_fence(__ATOMIC_ACQUIRE, "agent");
            xb_add(&bar[XB_XGEN(b.x)], 1u);
            asm volatile("s_waitcnt vmcnt(0)" ::: "memory");
        } else {
            XB_SPIN(xb_ld(&bar[XB_XGEN(b.x)]) == gen, bar);
            __builtin_amdgcn_fence(__ATOMIC_ACQUIRE, "agent");
            asm volatile("s_waitcnt vmcnt(0)" ::: "memory");
        }
    }
    __syncthreads();
}

namespace pg8 {
constexpr int BM = 256, BK = 64, HALF = 128, HTB = HALF * BK * 2, STAGE_BYTES = 8 * HTB, NXCD = 8, WGM = 8;
__host__ __device__ __forceinline__ int lds_byte(int r, int c) { const int st = (r >> 4) * 2 + (c >> 5), rr = r & 15, cc = c & 31, ob = rr * 64 + cc * 2; return st * 1024 + (ob ^ (((ob >> 9) & 1) << 5)); }
__host__ __device__ __forceinline__ void stage_rc(int b, int& R, int& C) { const int st = b / 1024, sb = b % 1024, swz = sb ^ (((sb >> 9) & 1) << 5); R = (st >> 1) * 16 + swz / 64; C = (st & 1) * 32 + (swz % 64) / 2; }
__host__ __device__ __forceinline__ int perm32(int rho) { const int n = rho >> 4, i = rho & 15; return 8 * (i >> 2) + 4 * n + (i & 3); }
struct Unit { int pm, pn; };
struct Gemm { const bf16_t* A; const bf16_t* Bt; int M, N, K; };
struct StaticOrder {
    int nM, nN, nwg, G, c;
    __host__ __device__ void init(int M_, int N_, int G_, int c_) { nM = M_ / BM; nN = N_ / BM; nwg = nM * nN; G = G_; c = c_; }
    __host__ __device__ bool next(int i, Unit& u) const {
        const long L = (long)i * G + c; if (L >= nwg) return false;
        int wgid = (int)L; { const int q = nwg / NXCD, r = nwg % NXCD, xcd = wgid % NXCD, off = wgid / NXCD; wgid = (xcd < r ? xcd * (q + 1) : r * (q + 1) + (xcd - r) * q) + off; }
        const int nig = WGM * nN, gid = wgid / nig, fm = gid * WGM, gsz = (nM - fm) < WGM ? (nM - fm) : WGM;
        u.pm = fm + ((wgid % nig) % gsz); u.pn = (wgid % nig) / gsz; return true;
    }
};
template <class Epi, class Sched, bool ALIGN_EPI, bool SP2>
__device__ __forceinline__ void gemm_phase(LAS unsigned char* lds, const Gemm g, const Sched& S, const Epi& E) {
    const int tid = threadIdx.x, wid = __builtin_amdgcn_readfirstlane(tid >> 6), lane = tid & 63, wr = wid >> 2, wc = wid & 3, fr = lane & 15, fq = lane >> 4;
    const int K = g.K, nt = K / BK;
    unsigned voffA[2], voffB[2];
#pragma unroll
    for (int i = 0; i < 2; ++i) { int R, C; stage_rc(tid * 16 + i * 8192, R, C); const int Rb = Epi::brow(R);
        voffA[i] = (unsigned)(R * K + C) * 2u; voffB[i] = (unsigned)(Rb * K + C) * 2u; }
    const size_t kstep = (size_t)(BK * 2);
    const size_t hstep = (size_t)HALF * K * 2;
    const size_t hstepB = (size_t)Epi::BHALF * K * 2;
    const size_t tstep = 2 * hstep;
    const unsigned ldsw = (unsigned)wid * 1024u;
    const int aoff = lds_byte(wr * 64 + fr, fq * 8), boff = lds_byte(wc * 32 + fr, fq * 8);
#define PG8_SA(b, h) (((b) * 2 + (h)) * HTB)
#define PG8_SB(b, h) ((4 + (b) * 2 + (h)) * HTB)
#define PG8_STAGE(bufoff, gbase, voff) do { _Pragma("unroll") for (int _i = 0; _i < 2; ++_i) \
        __builtin_amdgcn_global_load_lds((const unsigned*)((const char*)(gbase) + (voff)[_i]), (LAS unsigned*)(lds + (bufoff) + ldsw + _i * 8192), 16, 0, 0); } while (0)
#define PG8_LDA(dst, b, h) do { _Pragma("unroll") for (int m = 0; m < 4; ++m) _Pragma("unroll") for (int k = 0; k < 2; ++k) dst[m][k] = *(const LAS bf16x8*)(lds + PG8_SA(b, h) + aoff + m * 2048 + k * 1024); } while (0)
#define PG8_LDB(dst, b, h) do { _Pragma("unroll") for (int n = 0; n < 2; ++n) _Pragma("unroll") for (int k = 0; k < 2; ++k) dst[n][k] = *(const LAS bf16x8*)(lds + PG8_SB(b, h) + boff + n * 2048 + k * 1024); } while (0)
#define PG8_MMA(ai, bj, At, Bt) do { __builtin_amdgcn_s_setprio(1); _Pragma("unroll") for (int m = 0; m < 4; ++m) _Pragma("unroll") for (int n = 0; n < 2; ++n) _Pragma("unroll") for (int k = 0; k < 2; ++k) \
        acc[ai][bj][m][n] = __builtin_amdgcn_mfma_f32_16x16x32_bf16(Bt[n][k], At[m][k], acc[ai][bj][m][n], 0, 0, 0); __builtin_amdgcn_s_setprio(0); } while (0)
#define PG8_WAIT_V(n) asm volatile("s_waitcnt vmcnt(" #n ")" ::: "memory")
#define PG8_WAIT_L(n) asm volatile("s_waitcnt lgkmcnt(" #n ")" ::: "memory")
#define PG8_BAR __builtin_amdgcn_s_barrier()
#define PG8_SCHED __builtin_amdgcn_sched_barrier(0)
    Unit cur, nxt; int ui = 0;
    if (!S.next(0, cur)) return;
    f32x4 acc[2][2][4][2];
#pragma unroll
    for (int a = 0; a < 2; ++a)
#pragma unroll
        for (int b = 0; b < 2; ++b)
#pragma unroll
            for (int m = 0; m < 4; ++m)
#pragma unroll
                for (int n = 0; n < 2; ++n) acc[a][b][m][n] = (f32x4){0.f, 0.f, 0.f, 0.f};
    bf16x8 At[4][2], B0[2][2], B1[2][2];
    const char* cA = (const char*)g.A + (size_t)cur.pm * tstep; const char* cB = (const char*)g.Bt + (size_t)cur.pn * tstep;
    if constexpr (SP2) {
        PG8_STAGE(PG8_SB(0, 0), cB, voffB); PG8_STAGE(PG8_SB(0, 1), cB + hstepB, voffB); PG8_STAGE(PG8_SA(0, 0), cA, voffA); PG8_STAGE(PG8_SA(0, 1), cA + hstep, voffA);
        if (wr == 1) PG8_BAR;
        PG8_WAIT_V(2); PG8_BAR;
        PG8_STAGE(PG8_SB(1, 0), cB + kstep, voffB); PG8_STAGE(PG8_SA(1, 0), cA + kstep, voffA); PG8_STAGE(PG8_SB(1, 1), cB + hstepB + kstep, voffB);
        PG8_WAIT_V(6); PG8_BAR;
    } else {
        PG8_STAGE(PG8_SB(0, 0), cB, voffB); PG8_STAGE(PG8_SA(0, 0), cA, voffA); PG8_STAGE(PG8_SB(0, 1), cB + hstepB, voffB); PG8_STAGE(PG8_SA(0, 1), cA + hstep, voffA);
        if (wr == 1) PG8_BAR;
        PG8_WAIT_V(4); PG8_BAR;
        PG8_STAGE(PG8_SB(1, 0), cB + kstep, voffB); PG8_STAGE(PG8_SA(1, 0), cA + kstep, voffA); PG8_STAGE(PG8_SB(1, 1), cB + hstepB + kstep, voffB);
        PG8_WAIT_V(6); PG8_BAR;
    }
    for (;;) {
        const bool has_next = S.next(ui + 1, nxt);
        const char* nA = has_next ? (const char*)g.A + (size_t)nxt.pm * tstep : cA; const char* nB = has_next ? (const char*)g.Bt + (size_t)nxt.pn * tstep : cB;
        for (int t = 0; t < nt; t += 2) {
            const bool last = (t == nt - 2);
            const char* a1 = cA + (size_t)(t + 1) * kstep;
            const char* a2 = last ? nA : cA + (size_t)(t + 2) * kstep; const char* b2 = last ? nB : cB + (size_t)(t + 2) * kstep;
            const char* a3 = a2 + kstep; const char* b3 = b2 + kstep;
            if constexpr (SP2) {
            PG8_LDB(B0, 0, 0); PG8_LDB(B1, 0, 1); PG8_SCHED; PG8_LDA(At, 0, 0); PG8_STAGE(PG8_SA(1, 1), a1 + hstep, voffA);
            PG8_WAIT_V(8); PG8_WAIT_L(0); PG8_BAR; PG8_MMA(0, 0, At, B0); PG8_MMA(0, 1, At, B1); PG8_BAR; PG8_SCHED;
            PG8_LDA(At, 0, 1); PG8_STAGE(PG8_SB(0, 0), b2, voffB); PG8_STAGE(PG8_SB(0, 1), b2 + hstepB, voffB); PG8_STAGE(PG8_SA(0, 0), a2, voffA);
            PG8_WAIT_V(8); PG8_WAIT_L(0); PG8_BAR; PG8_MMA(1, 0, At, B0); PG8_MMA(1, 1, At, B1); PG8_BAR; PG8_SCHED;
            PG8_LDB(B0, 1, 0); PG8_LDB(B1, 1, 1); PG8_SCHED; PG8_LDA(At, 1, 0); PG8_STAGE(PG8_SA(0, 1), a2 + hstep, voffA);
            PG8_WAIT_V(8); PG8_WAIT_L(0); PG8_BAR; PG8_MMA(0, 0, At, B0); PG8_MMA(0, 1, At, B1); PG8_BAR; PG8_SCHED;
            PG8_LDA(At, 1, 1); PG8_STAGE(PG8_SB(1, 0), b3, voffB); PG8_STAGE(PG8_SB(1, 1), b3 + hstepB, voffB); PG8_STAGE(PG8_SA(1, 0), a3, voffA);
            PG8_WAIT_V(8); PG8_WAIT_L(0); PG8_BAR; PG8_MMA(1, 0, At, B0); PG8_MMA(1, 1, At, B1); PG8_BAR; PG8_SCHED;
            } else {
            PG8_LDB(B0, 0, 0); PG8_SCHED; PG8_LDA(At, 0, 0); PG8_STAGE(PG8_SA(1, 1), a1 + hstep, voffA);
            PG8_WAIT_L(8); PG8_BAR; PG8_WAIT_L(0); PG8_MMA(0, 0, At, B0); PG8_BAR; PG8_SCHED;
            PG8_LDB(B1, 0, 1); PG8_STAGE(PG8_SB(0, 0), b2, voffB);
            PG8_BAR; PG8_WAIT_L(0); PG8_MMA(0, 1, At, B1); PG8_BAR;
            PG8_LDA(At, 0, 1); PG8_STAGE(PG8_SA(0, 0), a2, voffA);
            PG8_BAR; PG8_WAIT_L(0); PG8_MMA(1, 0, At, B0); PG8_BAR; PG8_SCHED;
            PG8_STAGE(PG8_SB(0, 1), b2 + hstepB, voffB);
            PG8_WAIT_V(6); PG8_BAR; PG8_MMA(1, 1, At, B1); PG8_BAR;
            PG8_LDB(B0, 1, 0); PG8_SCHED; PG8_LDA(At, 1, 0); PG8_STAGE(PG8_SA(0, 1), a2 + hstep, voffA);
            PG8_WAIT_L(8); PG8_BAR; PG8_WAIT_L(0); PG8_MMA(0, 0, At, B0); PG8_BAR; PG8_SCHED;
            PG8_LDB(B1, 1, 1); PG8_STAGE(PG8_SB(1, 0), b3, voffB);
            PG8_BAR; PG8_WAIT_L(0); PG8_MMA(0, 1, At, B1); PG8_BAR;
            PG8_LDA(At, 1, 1); PG8_STAGE(PG8_SA(1, 0), a3, voffA);
            PG8_BAR; PG8_WAIT_L(0); PG8_MMA(1, 0, At, B0); PG8_BAR; PG8_SCHED;
            PG8_STAGE(PG8_SB(1, 1), b3 + hstepB, voffB);
            PG8_WAIT_V(6); PG8_BAR; PG8_MMA(1, 1, At, B1); PG8_BAR;
            }
        }
        if constexpr (ALIGN_EPI) { if (wr == 0) PG8_BAR; }
        E(acc, cur, wr, wc, fr, fq);
        if (!has_next) break;
#pragma unroll
        for (int a = 0; a < 2; ++a)
#pragma unroll
            for (int b = 0; b < 2; ++b)
#pragma unroll
                for (int m = 0; m < 4; ++m)
#pragma unroll
                    for (int n = 0; n < 2; ++n) acc[a][b][m][n] = (f32x4){0.f, 0.f, 0.f, 0.f};
        cur = nxt; cA = nA; cB = nB; ++ui;
        if constexpr (ALIGN_EPI) { if (wr == 1) PG8_BAR; }
    }
    PG8_WAIT_V(0);
    if constexpr (!ALIGN_EPI) { if (wr == 0) PG8_BAR; }
    PG8_BAR;
#undef PG8_SA
#undef PG8_SB
#undef PG8_STAGE
#undef PG8_LDA
#undef PG8_LDB
#undef PG8_MMA
#undef PG8_WAIT_V
#undef PG8_WAIT_L
#undef PG8_BAR
#undef PG8_SCHED
}
}

struct EpiIn {
    static constexpr int BHALF = 32;
    __host__ __device__ static int brow(int R) { return 64 * (R >> 5) + pg8::perm32(R & 31); }
    bf16_t* HM; const LAS float* lgain;
    DI void operator()(const f32x4 (&acc)[2][2][4][2], const pg8::Unit& u, int wr, int wc, int fr, int fq) const {
        const int row0 = u.pm * 256 + wr * 64 + fr;
        const int slot = u.pn * 4 + wc;
        bf16_t* base = HM + ((size_t)slot * M + row0) * 64 + 8 * fq;
        const LAS float* gain = lgain; float extra = 1.f; int kind = 0;
        if (slot < 8) { extra = 0.125f * LOG2E; kind = 1; }
        else if (slot < 10) { gain = lgain + 64; kind = 1; }
        else if (slot < 12) kind = 0;
        else if (slot < 20) kind = 2;
        else if (slot < 28) { gain = lgain + 128; extra = 0.125f * LOG2E; kind = 1; }
        else if (slot < 32) kind = 0;
        else if (slot < 34) { gain = lgain + 192; kind = 1; }
        else if (slot < 36) kind = 0;
        else if (slot < 38) { gain = lgain + 256; kind = 1; }
        else if (slot < 40) kind = 0;
        else kind = 2;
        if (kind == 1) {
            f32x4 gv[2][2];
#pragma unroll
            for (int bj = 0; bj < 2; ++bj)
#pragma unroll
                for (int n = 0; n < 2; ++n) gv[bj][n] = *(const LAS f32x4*)(gain + 32 * bj + 8 * fq + 4 * n);
#pragma unroll
            for (int ai = 0; ai < 2; ++ai)
#pragma unroll
                for (int m = 0; m < 4; ++m) {
                    float ss = 0.f;
#pragma unroll
                    for (int bj = 0; bj < 2; ++bj)
#pragma unroll
                        for (int n = 0; n < 2; ++n) { const f32x4 a = acc[ai][bj][m][n]; ss += (a.x * a.x + a.y * a.y) + (a.z * a.z + a.w * a.w); }
                    ss += __shfl_xor(ss, 16); ss += __shfl_xor(ss, 32);
                    const float rs = rsq(ss * (1.f / 64.f) + EPS) * extra;
#pragma unroll
                    for (int bj = 0; bj < 2; ++bj) { const f32x4 v0 = acc[ai][bj][m][0] * rs * gv[bj][0], v1 = acc[ai][bj][m][1] * rs * gv[bj][1];
                        u32x4 w; w.x = pk2(v0.x, v0.y); w.y = pk2(v0.z, v0.w); w.z = pk2(v1.x, v1.y); w.w = pk2(v1.z, v1.w);
                        *(u32x4*)(base + (size_t)(ai * 128 + m * 16) * 64 + 32 * bj) = w; }
                }
        } else {
#pragma unroll
            for (int ai = 0; ai < 2; ++ai)
#pragma unroll
                for (int m = 0; m < 4; ++m)
#pragma unroll
                    for (int bj = 0; bj < 2; ++bj) { f32x4 v0 = acc[ai][bj][m][0], v1 = acc[ai][bj][m][1];
                        if (kind == 2) { v0.x *= sigm(v0.x); v0.y *= sigm(v0.y); v0.z *= sigm(v0.z); v0.w *= sigm(v0.w);
                                         v1.x *= sigm(v1.x); v1.y *= sigm(v1.y); v1.z *= sigm(v1.z); v1.w *= sigm(v1.w); }
                        u32x4 w; w.x = pk2(v0.x, v0.y); w.y = pk2(v0.z, v0.w); w.z = pk2(v1.x, v1.y); w.w = pk2(v1.z, v1.w);
                        *(u32x4*)(base + (size_t)(ai * 128 + m * 16) * 64 + 32 * bj) = w; }
        }
    }
};
struct EpiOut {
    static constexpr int BHALF = 128;
    __host__ __device__ static int brow(int R) { return R; }
    const float* x; const float* mod; float* out;
    DI void operator()(const f32x4 (&acc)[2][2][4][2], const pg8::Unit& u, int wr, int wc, int fr, int fq) const {
        const int row0 = u.pm * 256 + wr * 64 + fr, col0 = u.pn * 256 + wc * 32 + 4 * fq;
        const float* gate = mod + (u.pm >> 4) * 3072 + 2048 + col0;
        __builtin_amdgcn_s_waitcnt(0x0F70);
        __builtin_amdgcn_sched_barrier(0);
        f32x4 gv[2][2];
#pragma unroll
        for (int bj = 0; bj < 2; ++bj)
#pragma unroll
            for (int n = 0; n < 2; ++n) gv[bj][n] = *(const f32x4*)(gate + bj * 128 + n * 16);
        f32x4 xa[2][2][2], xb[2][2][2];
#define EO_OFF(q, mm) ((size_t)(row0 + ((q) >> 1) * 128 + (((q) & 1) * 2 + (mm)) * 16) * 1024 + col0)
#define EO_LOAD(XV, q) do { _Pragma("unroll") for (int mm = 0; mm < 2; ++mm) _Pragma("unroll") for (int bj = 0; bj < 2; ++bj) _Pragma("unroll") for (int n = 0; n < 2; ++n) \
            XV[mm][bj][n] = *(const f32x4*)(x + EO_OFF(q, mm) + bj * 128 + n * 16); } while (0)
#define EO_STORE(XV, q) do { _Pragma("unroll") for (int mm = 0; mm < 2; ++mm) _Pragma("unroll") for (int bj = 0; bj < 2; ++bj) _Pragma("unroll") for (int n = 0; n < 2; ++n) \
            *(f32x4*)(out + EO_OFF(q, mm) + bj * 128 + n * 16) = XV[mm][bj][n] + gv[bj][n] * acc[(q) >> 1][bj][((q) & 1) * 2 + mm][n]; } while (0)
        EO_LOAD(xa, 0);
        __builtin_amdgcn_sched_barrier(0);
        EO_LOAD(xb, 1);
        __builtin_amdgcn_sched_barrier(0);
        EO_STORE(xa, 0);
        __builtin_amdgcn_sched_barrier(0);
        EO_LOAD(xa, 2);
        __builtin_amdgcn_sched_barrier(0);
        EO_STORE(xb, 1);
        __builtin_amdgcn_sched_barrier(0);
        EO_LOAD(xb, 3);
        __builtin_amdgcn_sched_barrier(0);
        EO_STORE(xa, 2);
        EO_STORE(xb, 3);
        asm volatile("" ::: "memory");
#undef EO_OFF
#undef EO_LOAD
#undef EO_STORE
    }
};

DI void p0_mod_a(const Params& p, char* lds, int ht) {
    float* sc = (float*)lds;
    for (int i = ht; i < 16384; i += 256) { const int b = i >> 10, k = i & 1023; const float cv = p.c[i]; sc[k * 16 + b] = cv * sigm(cv); }
}
DI void p0_mod_b(const Params& p, int item, char* lds, int ht) {
    const int col = ht & 15, kg = ht >> 4, n0 = item * 16;
    const float* sc = (const float*)lds; float* red = (float*)(lds + 65536);
    float acc[16];
#pragma unroll
    for (int b = 0; b < 16; ++b) acc[b] = 0.f;
#pragma unroll 1
    for (int c = 0; c < 4; ++c) {
        float wv[16];
#pragma unroll
        for (int kk = 0; kk < 16; ++kk) wv[kk] = p.w_ada[(size_t)(kg * 64 + c * 16 + kk) * 3072 + n0 + col];
#pragma unroll 4
        for (int kk = 0; kk < 16; ++kk) {
            const int k = kg * 64 + c * 16 + kk;
            const float w = wv[kk];
            const f32x4* s4 = (const f32x4*)(sc + k * 16);
#pragma unroll
            for (int q = 0; q < 4; ++q) { const f32x4 s = s4[q]; acc[4 * q] += s.x * w; acc[4 * q + 1] += s.y * w; acc[4 * q + 2] += s.z * w; acc[4 * q + 3] += s.w * w; }
        }
    }
#pragma unroll
    for (int b = 0; b < 16; ++b) { float a = acc[b]; a += __shfl_xor(a, 16); a += __shfl_xor(a, 32); if ((ht & 63) < 16) red[((ht >> 6) * 16 + b) * 16 + col] = a; }
}
DI void p0_mod_c(const Params& p, int item, char* lds, int ht, float* mod) {
    const int col = ht & 15, b = ht >> 4, n0 = item * 16; const float* red = (const float*)(lds + 65536);
    const float s = (red[(0 * 16 + b) * 16 + col] + red[(1 * 16 + b) * 16 + col]) + (red[(2 * 16 + b) * 16 + col] + red[(3 * 16 + b) * 16 + col]);
    mod[b * 3072 + n0 + col] = s + p.b_ada[n0 + col];
}
DI void p0_tr_a(const float* src, int N, int kb, int nb, char* lds, int ht) {
    float* t = (float*)lds; const int k0 = kb * 64, n0 = nb * 64;
#pragma unroll 4
    for (int i = 0; i < 16; ++i) { const int r = i * 4 + (ht >> 6), cc = ht & 63;
        t[r * 65 + cc] = (n0 + cc < N) ? src[(size_t)(k0 + r) * N + n0 + cc] : 0.f; }
}
DI void p0_tr_b(bf16_t* dst, int K, int kb, int nb, char* lds, int ht) {
    const float* t = (const float*)lds; const int k0 = kb * 64, n0 = nb * 64, n = ht >> 2, kc = (ht & 3) * 16;
    u32x4 o0, o1;
    o0.x = pk2(t[(kc + 0) * 65 + n], t[(kc + 1) * 65 + n]); o0.y = pk2(t[(kc + 2) * 65 + n], t[(kc + 3) * 65 + n]);
    o0.z = pk2(t[(kc + 4) * 65 + n], t[(kc + 5) * 65 + n]); o0.w = pk2(t[(kc + 6) * 65 + n], t[(kc + 7) * 65 + n]);
    o1.x = pk2(t[(kc + 8) * 65 + n], t[(kc + 9) * 65 + n]); o1.y = pk2(t[(kc + 10) * 65 + n], t[(kc + 11) * 65 + n]);
    o1.z = pk2(t[(kc + 12) * 65 + n], t[(kc + 13) * 65 + n]); o1.w = pk2(t[(kc + 14) * 65 + n], t[(kc + 15) * 65 + n]);
    u32x4* d = (u32x4*)(dst + (size_t)(n0 + n) * K + k0 + kc); d[0] = o0; d[1] = o1;
}
DI void p0_b1_a(const Params& p, int item, char* lds, int ht) {
    const int kv = item >> 2, n0 = (item & 3) * 64, col = ht & 63, kg = ht >> 6;
    const float* pos = kv ? p.cmp_pos_v : p.cmp_pos_k; const float* w1 = kv ? p.w_cmp_v1 : p.w_cmp_k1;
    float a = 0.f;
#pragma unroll 8
    for (int kk = 0; kk < 512; ++kk) { const int k = kg * 512 + kk; a += pos[k] * w1[(size_t)k * 256 + n0 + col]; }
    ((float*)lds)[kg * 64 + col] = a;
}
DI void p0_b1_b(int item, char* lds, int ht, float* bias1) {
    const float* red = (const float*)lds; const int kv = item >> 2, n0 = (item & 3) * 64;
    if (ht < 64) bias1[kv * 256 + n0 + ht] = (red[ht] + red[64 + ht]) + (red[128 + ht] + red[192 + ht]);
}
DI void p0_tbl(const Params& p, int kind, int ht, float* T) {
    const float* gq = kind == 0 ? p.q_gain_a : p.q_gain_b; const float* gk = kind == 0 ? p.k_gain_a : (kind == 1 ? p.k_gain_sel : p.k_gain_win);
    const int head0 = kind == 0 ? 0 : 8;
    float gm = 0.f;
    for (int d = 0; d < 64; ++d) gm = fmaxf(gm, fabsf(gq[d] * gk[d]));
    for (int idx = ht; idx < 8 * 464; idx += 256) { const int r = idx / 464, rem = idx - r * 464, cp = rem / 232, i = rem - cp * 232;
        int dist = 191 - i - cp; dist = dist < 0 ? 0 : (dist > 128 ? 128 : dist);
        float bm = 0.f;
        for (int bk = 0; bk < 32; ++bk) bm = fmaxf(bm, p.rel_bias[bk * 16 + head0 + r]);
        const float shift = 8.f * gm + bm;
        T[(kind * 8 + r) * 464 + rem] = (p.rel_bias[t5_bucket(dist) * 16 + head0 + r] - shift) * LOG2E;
        if (rem == 0) T[3 * 8 * 464 + kind * 8 + r] = shift; }
    if (ht == 0) T[3 * 8 * 464 + 25 + kind] = -8.f * gm * LOG2E;
    if (kind == 0 && ht == 0) { float gc = 0.f; for (int d = 0; d < 64; ++d) gc = fmaxf(gc, fabsf(p.q_gain_b[d] * p.k_gain_cmp[d])); T[3 * 8 * 464 + 24] = -8.f * gc * LOG2E; }
}
DI void phase0(const Params& p, char* lds0) {
    float* mod = (float*)(p.ws + WS_MOD); float* bias1 = (float*)(p.ws + WS_BIAS1);
    bf16_t* WinT = (bf16_t*)(p.ws + WS_WINT); bf16_t* WoutT = (bf16_t*)(p.ws + WS_WOUTT);
    bf16_t* W1T = (bf16_t*)(p.ws + WS_W1T); bf16_t* W2T = (bf16_t*)(p.ws + WS_W2T);
    constexpr int I_MOD = 192, I_TBL = 3, I_B1 = 8, I_WIN = 16 * 48, I_WOUT = 16 * 16, I_W1 = 32 * 4, I_W2 = 4;
    constexpr int NITEMS = I_MOD + I_TBL + I_B1 + I_WIN + I_WOUT + 2 * I_W1 + 2 * I_W2;
    const int half = threadIdx.x >> 8, ht = threadIdx.x & 255;
    char* lds = lds0 + half * 73728;
    for (int it = blockIdx.x; 2 * it < NITEMS; it += gridDim.x) {
        const int item = 2 * it + half; const bool valid = item < NITEMS;
        int r = item, type = -1, a = 0;
        const float* src = nullptr; bf16_t* dst = nullptr; int K = 0, N = 0, kb = 0, nb = 0;
        if (valid) {
            if (r < I_MOD) { type = 0; a = r; }
            else if ((r -= I_MOD) < I_TBL) { type = 3; a = r; }
            else if ((r -= I_TBL) < I_B1) { type = 1; a = r; }
            else if ((r -= I_B1) < I_WIN) { type = 2; src = p.w_in; dst = WinT; K = 1024; N = NPROJ; kb = r / 48; nb = r % 48; }
            else if ((r -= I_WIN) < I_WOUT) { type = 2; src = p.w_out; dst = WoutT; K = 1024; N = 1024; kb = r / 16; nb = r % 16; }
            else if ((r -= I_WOUT) < I_W1) { type = 2; src = p.w_cmp_k1; dst = W1T; K = 2048; N = 256; kb = r / 4; nb = r % 4; }
            else if ((r -= I_W1) < I_W1) { type = 2; src = p.w_cmp_v1; dst = W1T + 256 * 2048; K = 2048; N = 256; kb = r / 4; nb = r % 4; }
            else if ((r -= I_W1) < I_W2) { type = 2; src = p.w_cmp_k2; dst = W2T; K = 256; N = 64; kb = r; nb = 0; }
            else { r -= I_W2; type = 2; src = p.w_cmp_v2; dst = W2T + 64 * 256; K = 256; N = 64; kb = r; nb = 0; }
        }
        if (type == 0) p0_mod_a(p, lds, ht); else if (type == 3) p0_tbl(p, a, ht, (float*)(p.ws + WS_TBL));
        __syncthreads();
        if (type == 0) p0_mod_b(p, a, lds, ht); else if (type == 1) p0_b1_a(p, a, lds, ht); else if (type == 2) p0_tr_a(src, N, kb, nb, lds, ht);
        __syncthreads();
        if (type == 0) p0_mod_c(p, a, lds, ht, mod); else if (type == 1) p0_b1_b(a, lds, ht, bias1); else if (type == 2) p0_tr_b(dst, K, kb, nb, lds, ht);
        __syncthreads();
    }
}

constexpr int L1_AB = 0, L1_WG = 8192, L1_WGS = 2064  , L1_WGROWS = 25  , L1_SS = L1_WG + L1_WGROWS * L1_WGS,
              L1_ACCS = 36  , L1_ACCB = 2 * 128 * L1_ACCS * 4, L1_ACC = L1_SS + 2 * 1024, L1_VB = L1_ACC + 2 * L1_ACCB, L1_END = L1_VB + 128;
static_assert(L1_END <= 147456 && L1_SS % 16 == 0 && L1_ACC % 16 == 0, "P1 LDS map");
DI void phase1(const Params& p, char* lds) {
    bf16_t* H = (bf16_t*)(p.ws + WS_H); float* GB = (float*)(p.ws + WS_GB); const float* mod = (const float*)(p.ws + WS_MOD);
    float* AB = (float*)(lds + L1_AB); float* VB = (float*)(lds + L1_VB);
    for (int rt = blockIdx.x; rt < M / 256; rt += gridDim.x) {
        int tid_ = threadIdx.x; asm volatile("" : "+v"(tid_));
        const int tid = tid_, lane = tid & 63, w = tid >> 6, tok = lane & 15, kq = lane >> 4;
        const int b = rt >> 4;
        const float* shift = mod + b * 3072; const float* scale = shift + 1024;
        __syncthreads();
        for (int k = tid; k < 1024; k += NTHREADS) { AB[k] = p.norm_gain[k] * (1.f + scale[k]); AB[1024 + k] = shift[k]; }
        __syncthreads();
        { const int c = tid & 31, kc = tid >> 5; float av = 0.f;
#pragma unroll 8
          for (int it = 0; it < 64; ++it) { const int k = kc + 16 * it; const float wr = c < 24 ? p.w_in[(size_t)k * NPROJ + 3072 + c] : 0.f;
              av += AB[1024 + k] * wr;
              if (c < L1_WGROWS) *(bf16_t*)(lds + L1_WG + c * L1_WGS + k * 2) = (bf16_t)(pk2(wr * AB[k], 0.f) & 0xffffu); }
          ((float*)(lds + L1_ACC))[kc * 32 + c] = av; }
        __syncthreads();
        if (tid < 32) { float a = 0.f; for (int kc = 0; kc < 16; ++kc) a += ((const float*)(lds + L1_ACC))[kc * 32 + tid]; VB[tid] = a + (tid < 24 ? p.b_gate[tid] : 0.f); }
        __syncthreads();
        const float* xb = p.x + ((size_t)rt * 256 + tok) * 1024 + 128 * w + 8 * kq;
        const char* wgA = lds + L1_WG + tok * L1_WGS + (128 * w + 8 * kq) * 2;
        const char* wgB = lds + L1_WG + (tok < 8 ? 16 + tok : 24) * L1_WGS + (128 * w + 8 * kq) * 2;
        f32x4 xsa[2][4][2], xsb[2][4][2];
#pragma unroll
        for (int r = 0; r < 2; ++r)
#pragma unroll
            for (int s = 0; s < 4; ++s) { xsa[r][s][0] = *(const f32x4*)(xb + r * 16 * 1024 + 32 * s); xsa[r][s][1] = *(const f32x4*)(xb + r * 16 * 1024 + 32 * s + 4); }
        auto step = [&](f32x4 (&xv)[2][4][2], f32x4 (&xl)[2][4][2], const int g) {
            if (g + 1 < 8) { const float* xg = xb + (size_t)(g + 1) * 32 * 1024;
#pragma unroll
                for (int r = 0; r < 2; ++r)
#pragma unroll
                    for (int s = 0; s < 4; ++s) { xl[r][s][0] = *(const f32x4*)(xg + r * 16 * 1024 + 32 * s); xl[r][s][1] = *(const f32x4*)(xg + r * 16 * 1024 + 32 * s + 4); } }
            float* SS = (float*)(lds + L1_SS + (g & 1) * 1024); float* ACC = (float*)(lds + L1_ACC + (g & 1) * L1_ACCB);
            float ss[2] = {0.f, 0.f}; f32x4 a0[2], a1[2];
#pragma unroll
            for (int r = 0; r < 2; ++r) { a0[r] = (f32x4){0.f, 0.f, 0.f, 0.f}; a1[r] = (f32x4){0.f, 0.f, 0.f, 0.f}; }
#pragma unroll
            for (int s = 0; s < 4; ++s) {
                const bf16x8 wf0 = *(const bf16x8*)(wgA + 64 * s), wf1 = *(const bf16x8*)(wgB + 64 * s);
#pragma unroll
                for (int r = 0; r < 2; ++r) {
                    const f32x4 u = xv[r][s][0], v = xv[r][s][1];
                    ss[r] += (u.x * u.x + u.y * u.y) + (u.z * u.z + u.w * u.w) + (v.x * v.x + v.y * v.y) + (v.z * v.z + v.w * v.w);
                    u32x4 pb; pb.x = pk2(u.x, u.y); pb.y = pk2(u.z, u.w); pb.z = pk2(v.x, v.y); pb.w = pk2(v.z, v.w);
                    const bf16x8 xf = __builtin_bit_cast(bf16x8, pb);
                    a0[r] = mfma16(wf0, xf, a0[r]); a1[r] = mfma16(wf1, xf, a1[r]);
                }
            }
#pragma unroll
            for (int r = 0; r < 2; ++r) {
                float t = ss[r]; t += __shfl_xor(t, 16); t += __shfl_xor(t, 32);
                if (kq == 0) SS[r * 128 + w * 16 + tok] = t;
                float* ar = ACC + (r * 128 + w * 16 + tok) * L1_ACCS + 4 * kq;
                *(f32x4*)ar = a0[r]; *(f32x4*)(ar + 16) = a1[r];
            }
            __syncthreads();
            float rstd[2];
#pragma unroll
            for (int r = 0; r < 2; ++r) { float t = 0.f;
#pragma unroll
                for (int ww = 0; ww < 8; ++ww) t += SS[r * 128 + ww * 16 + tok];
                rstd[r] = rsq(t * (1.f / 1024.f) + EPS); }
            bf16_t* hrow = H + ((size_t)rt * 256 + g * 32 + tok) * 1024 + 128 * w + 8 * kq;
#pragma unroll
            for (int s = 0; s < 4; ++s) { const int k = 128 * w + 32 * s + 8 * kq;
                const f32x4 g0 = *(const f32x4*)(AB + k), g1 = *(const f32x4*)(AB + k + 4), s0 = *(const f32x4*)(AB + 1024 + k), s1 = *(const f32x4*)(AB + 1024 + k + 4);
#pragma unroll
                for (int r = 0; r < 2; ++r) {
                    const f32x4 h0 = xv[r][s][0] * rstd[r] * g0 + s0, h1 = xv[r][s][1] * rstd[r] * g1 + s1;
                    u32x4 o; o.x = pk2(h0.x, h0.y); o.y = pk2(h0.z, h0.w); o.z = pk2(h1.x, h1.y); o.w = pk2(h1.z, h1.w);
                    *(u32x4*)(hrow + r * 16 * 1024 + 32 * s) = o; } }
            { const int t32 = tid >> 4, cp = tid & 15;
              const float* SSr = SS + (t32 >> 4) * 128 + (t32 & 15); const float* ACr = ACC + ((t32 >> 4) * 128 + (t32 & 15)) * L1_ACCS + cp;
              float t = 0.f, v0 = 0.f, v1 = 0.f;
#pragma unroll
              for (int ww = 0; ww < 8; ++ww) { t += SSr[ww * 16]; v0 += ACr[ww * 16 * L1_ACCS]; v1 += ACr[ww * 16 * L1_ACCS + 16]; }
              const float rs = rsq(t * (1.f / 1024.f) + EPS);
              float* gp = GB + ((size_t)rt * 256 + g * 32 + t32) * 24 + cp;
              gp[0] = sigm(rs * v0 + VB[cp]);
              if (cp < 8) gp[16] = sigm(rs * v1 + VB[16 + cp]); }
        };
#pragma unroll 1
        for (int g = 0; g < 8; g += 2) { step(xsa, xsb, g); step(xsb, xsa, g + 1); }
    }
}

DI void p3_item(const Params& p, int item, char* lds, int tid) {
    const int lane = tid & 63, w = tid >> 6;
    const int kv = item & 1, ct = (item >> 1) & 7, bg = item >> 4, b = bg >> 1, g = bg & 1;
    const bf16_t* HM = (const bf16_t*)(p.ws + WS_HM);
    const int slot = (kv ? 30 : 28) + g;
    const bf16_t* Xbase = HM + ((size_t)slot * M + (size_t)b * 4096) * 64;
    const bf16_t* W1 = (const bf16_t*)(p.ws + WS_W1T) + (size_t)kv * 256 * 2048;
    const bf16_t* W2 = (const bf16_t*)(p.ws + WS_W2T) + (size_t)kv * 64 * 256;
    const float* bias1 = (const float*)(p.ws + WS_BIAS1) + kv * 256;
    const int srow = tid >> 3, sch = tid & 7;
    const int sofs = srow * 128 + ((sch ^ ((srow >> 1) & 7)) << 4);
    int cx = ct * 32 + srow; if (cx > 254) cx = 254;
    const bf16_t* xp = Xbase + (size_t)cx * 1024 + sch * 8;
    const bf16_t* wp = W1 + (size_t)srow * 2048 + sch * 8;
    constexpr int STG = 36864;
    u32x4 wrA[8], wrB[8], xrA, xrB;
    f32x4 acc[4][2];
#pragma unroll
    for (int i = 0; i < 4; ++i) { acc[i][0] = (f32x4){0.f, 0.f, 0.f, 0.f}; acc[i][1] = (f32x4){0.f, 0.f, 0.f, 0.f}; }
#define P3_LOAD(WR, XR, KT) do { _Pragma("unroll") for (int q = 0; q < 8; ++q) WR[q] = *(const u32x4*)(wp + (size_t)q * 32 * 2048 + (KT) * 64); XR = *(const u32x4*)(xp + (KT) * 64); } while (0)
#define P3_STORE(WR, XR, BUF) do { char* d_ = lds + (BUF) * STG; _Pragma("unroll") for (int q = 0; q < 8; ++q) *(u32x4*)(d_ + sofs + q * 4096) = WR[q]; *(u32x4*)(d_ + 32768 + sofs) = XR; } while (0)
#define P3_COMPUTE(BUF) do { const char* sW = lds + (BUF) * STG; const char* sX = sW + 32768; \
        _Pragma("unroll") for (int ks = 0; ks < 2; ++ks) { const int co = ((ks * 4 + fq) ^ fsw) << 4; bf16x8 wf[4], xf[2]; \
            _Pragma("unroll") for (int i = 0; i < 4; ++i) wf[i] = *(const bf16x8*)(sW + (w * 64 + i * 16) * 128 + fro + co); \
            _Pragma("unroll") for (int i = 0; i < 2; ++i) xf[i] = *(const bf16x8*)(sX + (i * 16) * 128 + fro + co); \
            _Pragma("unroll") for (int ni = 0; ni < 4; ++ni) _Pragma("unroll") for (int mi = 0; mi < 2; ++mi) acc[ni][mi] = mfma16(wf[ni], xf[mi], acc[ni][mi]); } } while (0)
    const int fro = (lane & 15) * 128, fsw = (lane >> 1) & 7, fq = lane >> 4;
    P3_LOAD(wrA, xrA, 0); P3_LOAD(wrB, xrB, 1);
    P3_STORE(wrA, xrA, 0);
    __syncthreads();
    for (int kt = 0; kt < 32; kt += 2) {
        if (kt + 2 < 32) P3_LOAD(wrA, xrA, kt + 2);
        P3_COMPUTE(0);
        P3_STORE(wrB, xrB, 1);
        __syncthreads();
        if (kt + 3 < 32) P3_LOAD(wrB, xrB, kt + 3);
        P3_COMPUTE(1);
        if (kt + 2 < 32) P3_STORE(wrA, xrA, 0);
        __syncthreads();
    }
#undef P3_LOAD
#undef P3_STORE
#undef P3_COMPUTE
    char* Hs = lds;
    float* Os = (float*)(lds + 16384);
    {
        const int dq = (lane >> 4) * 4;
#pragma unroll
        for (int ni = 0; ni < 4; ++ni) { const int n = w * 64 + ni * 16 + dq; const f32x4 bv = *(const f32x4*)(bias1 + n);
#pragma unroll
            for (int mi = 0; mi < 2; ++mi) { const int m = mi * 16 + (lane & 15); const f32x4 a = acc[ni][mi] + bv;
                u32x2 o; o.x = pk2(a.x * sigm(a.x), a.y * sigm(a.y)); o.y = pk2(a.z * sigm(a.z), a.w * sigm(a.w));
                *(u32x2*)(Hs + m * 512 + (((n >> 3) ^ (m & 15)) << 4) + ((n >> 2) & 1) * 8) = o; } }
    }
    __syncthreads();
    {
        f32x4 a2[2] = {(f32x4){0.f, 0.f, 0.f, 0.f}, (f32x4){0.f, 0.f, 0.f, 0.f}};
        const bf16_t* w2p = W2 + (size_t)(w * 16 + (lane & 15)) * 256 + fq * 8;
#pragma unroll
        for (int ks = 0; ks < 8; ++ks) {
            const bf16x8 wf = *(const bf16x8*)(w2p + ks * 32);
#pragma unroll
            for (int mi = 0; mi < 2; ++mi) { const int m = mi * 16 + (lane & 15);
                const bf16x8 xf = *(const bf16x8*)(Hs + m * 512 + (((ks * 4 + fq) ^ (m & 15)) << 4));
                a2[mi] = mfma16(wf, xf, a2[mi]); }
        }
#pragma unroll
        for (int mi = 0; mi < 2; ++mi) *(f32x4*)(Os + (mi * 16 + (lane & 15)) * 68 + w * 16 + fq * 4) = a2[mi];
    }
    __syncthreads();
    {
        const int m = tid >> 3, d0 = (tid & 7) * 8;
        f32x4 v0 = *(const f32x4*)(Os + m * 68 + d0), v1 = *(const f32x4*)(Os + m * 68 + d0 + 4);
        if (kv == 0) {
            float ss = (v0.x * v0.x + v0.y * v0.y) + (v0.z * v0.z + v0.w * v0.w) + (v1.x * v1.x + v1.y * v1.y) + (v1.z * v1.z + v1.w * v1.w);
            ss += __shfl_xor(ss, 1); ss += __shfl_xor(ss, 2); ss += __shfl_xor(ss, 4);
            const float rs = rsq(ss * (1.f / 64.f) + EPS);
            v0 = v0 * rs * *(const f32x4*)(p.k_gain_cmp + d0); v1 = v1 * rs * *(const f32x4*)(p.k_gain_cmp + d0 + 4);
        }
        u32x4 o; o.x = pk2(v0.x, v0.y); o.y = pk2(v0.z, v0.w); o.z = pk2(v1.x, v1.y); o.w = pk2(v1.z, v1.w);
        *(u32x4*)((bf16_t*)(p.ws + (kv ? WS_VCMP : WS_KCMP)) + ((size_t)bg * 256 + ct * 32 + m) * 64 + d0) = o;
    }
    __syncthreads();
}
DI void phase3(const Params& p, char* lds) {
    const int half = threadIdx.x >> 8, ht = threadIdx.x & 255;
    for (int it = blockIdx.x; it < 256; it += gridDim.x) p3_item(p, 2 * it + half, lds + half * 73728, ht);
}

constexpr int L4_WSCR = 65536;
constexpr int L4_TBL0 = L4_WSCR + 8 * 8448;
constexpr int L4_TBL1 = L4_TBL0 + 7424;
constexpr int L4_SC = L4_TBL1 + 7424;
constexpr int L4_UNIT = L4_SC + 64;
static_assert(L4_UNIT + 16 <= LDS_MISC, "P4 LDS map");
struct WB { int hi_min, hi_max, lo_min, lo_max; };

template <int OFF> DI s16x4 tr_read(unsigned a) { s16x4 r; asm volatile("ds_read_b64_tr_b16 %0, %1 offset:%2" : "=&v"(r) : "v"(a), "i"(OFF) : "memory"); return r; }
#define TR_WAIT() do { asm volatile("s_waitcnt lgkmcnt(0)" ::: "memory"); __builtin_amdgcn_sched_barrier(0); } while (0)
#define PK8(L, H) (bf16x8){L[0], L[1], L[2], L[3], H[0], H[1], H[2], H[3]}
struct LaneC { int kA, vA0, vA1, Xc, h4; };
DI void pack_p(const f32x16& s, float& lsum, bf16x8 (&pf)[2]) {
    float e[16];
#pragma unroll
    for (int r = 0; r < 16; ++r) e[r] = ex2(s[r]);
    float t0 = (e[0] + e[1]) + (e[2] + e[3]), t1 = (e[4] + e[5]) + (e[6] + e[7]), t2 = (e[8] + e[9]) + (e[10] + e[11]), t3 = (e[12] + e[13]) + (e[14] + e[15]);
    lsum += (t0 + t1) + (t2 + t3);
#pragma unroll
    for (int s2 = 0; s2 < 2; ++s2) { u32x4 pp; pp.x = pk2(e[8 * s2 + 0], e[8 * s2 + 1]); pp.y = pk2(e[8 * s2 + 2], e[8 * s2 + 3]);
        pp.z = pk2(e[8 * s2 + 4], e[8 * s2 + 5]); pp.w = pk2(e[8 * s2 + 6], e[8 * s2 + 7]); pf[s2] = __builtin_bit_cast(bf16x8, pp); }
}
DI void subtile2_pv(const char* lds, int stoff  , int k0, const LaneC& lc, const bf16x8 (&qa)[4], const bf16x8 (&qb)[4],
                    f32x16 (&OA)[2], f32x16 (&OB)[2], float& lA, float& lB,
                    const f32x16& cin  , float tadd  , bool use_tbl, int tboffA, int tboffB,
                    bool need_hi, int hi_t, bool need_lo, int lo_t) {
    f32x16 sa, sb;
    bf16x8 kf[4];
#pragma unroll
    for (int ks = 0; ks < 4; ++ks) kf[ks] = *(const bf16x8*)(lds + stoff + (lc.kA ^ (ks << 5)));
    if (use_tbl) {
#pragma unroll
        for (int i = 0; i < 16; ++i) { sa[i] = 0.f; sb[i] = 0.f; }
    } else { sa = cin; sb = cin; }
    __builtin_amdgcn_s_setprio(1);
#pragma unroll
    for (int ks = 0; ks < 4; ++ks) { sa = mfma32(kf[ks], qa[ks], sa); sb = mfma32(kf[ks], qb[ks], sb); }
    __builtin_amdgcn_s_setprio(0);
    if (use_tbl) {
        const int X = lc.Xc + k0; const int to = (X & 1) * 928 + (X & ~1) * 4; const char* tpa = lds + tboffA + to; const char* tpb = lds + tboffB + to;
#pragma unroll
        for (int q = 0; q < 4; ++q) { const f32x2 t0 = *(const f32x2*)(tpa + 32 * q), t1 = *(const f32x2*)(tpa + 32 * q + 8);
            sa[4 * q] += t0.x + tadd; sa[4 * q + 1] += t0.y + tadd; sa[4 * q + 2] += t1.x + tadd; sa[4 * q + 3] += t1.y + tadd;
            const f32x2 u0 = *(const f32x2*)(tpb + 32 * q), u1 = *(const f32x2*)(tpb + 32 * q + 8);
            sb[4 * q] += u0.x + tadd; sb[4 * q + 1] += u0.y + tadd; sb[4 * q + 2] += u1.x + tadd; sb[4 * q + 3] += u1.y + tadd; }
    }
    if (need_hi) { const int H = hi_t - k0 - lc.h4;
#pragma unroll
        for (int r = 0; r < 16; ++r) { const bool ok = (r & 3) + 8 * (r >> 2) <= H; sa[r] = ok ? sa[r] : -INFINITY; sb[r] = ok ? sb[r] : -INFINITY; } }
    if (need_lo) { const int L = lo_t - k0 - lc.h4;
#pragma unroll
        for (int r = 0; r < 16; ++r) { const bool ok = (r & 3) + 8 * (r >> 2) >= L; sa[r] = ok ? sa[r] : -INFINITY; sb[r] = ok ? sb[r] : -INFINITY; } }
    const unsigned vb = (unsigned)(size_t)(LAS const char*)lds + (unsigned)(stoff + 8192);
    const unsigned va0 = vb + (unsigned)lc.vA0, va1 = vb + (unsigned)lc.vA1;
    const s16x4 a0 = tr_read<0>(va0), a1 = tr_read<1024>(va0), a2 = tr_read<2048>(va0), a3 = tr_read<3072>(va0);
    const s16x4 b0 = tr_read<0>(va1), b1 = tr_read<1024>(va1), b2 = tr_read<2048>(va1), b3 = tr_read<3072>(va1);
    bf16x8 pa[2], pb[2];
    pack_p(sa, lA, pa);
    TR_WAIT();
    __builtin_amdgcn_s_setprio(1);
    OA[0] = mfma32(PK8(a0, a1), pa[0], OA[0]); OA[1] = mfma32(PK8(b0, b1), pa[0], OA[1]);
    OA[0] = mfma32(PK8(a2, a3), pa[1], OA[0]); OA[1] = mfma32(PK8(b2, b3), pa[1], OA[1]);
    __builtin_amdgcn_s_setprio(0);
    __builtin_amdgcn_sched_barrier(0);
    pack_p(sb, lB, pb);
    __builtin_amdgcn_sched_barrier(0);
    __builtin_amdgcn_s_setprio(1);
    OB[0] = mfma32(PK8(a0, a1), pb[0], OB[0]); OB[1] = mfma32(PK8(b0, b1), pb[0], OB[1]);
    OB[0] = mfma32(PK8(a2, a3), pb[1], OB[0]); OB[1] = mfma32(PK8(b2, b3), pb[1], OB[1]);
    __builtin_amdgcn_s_setprio(0);
}

DI void load_q(const bf16_t* HM, int slot, int m, int lane, bf16x8 (&qf)[4]) {
    const bf16_t* q = HM + ((size_t)slot * M + m) * 64 + (lane >> 5) * 8;
#pragma unroll
    for (int ks = 0; ks < 4; ++ks) qf[ks] = *(const bf16x8*)(q + ks * 16);
}
DI void write_y2(bf16_t* Y, const bf16_t* HM, int zslotA, int zslotB, int m, int colA, int colB, int lane, const f32x16 (&ya)[2], const f32x16 (&yb)[2]) {
    const int h = lane >> 5;
    const bf16_t* za = HM + ((size_t)zslotA * M + m) * 64 + 4 * h; const bf16_t* zb = HM + ((size_t)zslotB * M + m) * 64 + 4 * h;
    u32x2 zza[8], zzb[8];
#pragma unroll
    for (int i = 0; i < 8; ++i) { zza[i] = *(const u32x2*)(za + 8 * i); zzb[i] = *(const u32x2*)(zb + 8 * i); }
    asm volatile("" ::: "memory");
    bf16_t* ypa = Y + (size_t)m * 1024 + colA + 4 * h; bf16_t* ypb = Y + (size_t)m * 1024 + colB + 4 * h;
#pragma unroll
    for (int i = 0; i < 8; ++i) { const int db = i >> 2, rg = i & 3;
        u32x2 o; o.x = pk2(ya[db][4 * rg + 0] * bflo(zza[i].x), ya[db][4 * rg + 1] * bfhi(zza[i].x));
        o.y = pk2(ya[db][4 * rg + 2] * bflo(zza[i].y), ya[db][4 * rg + 3] * bfhi(zza[i].y));
        *(u32x2*)(ypa + 8 * i) = o;
        u32x2 q; q.x = pk2(yb[db][4 * rg + 0] * bflo(zzb[i].x), yb[db][4 * rg + 1] * bfhi(zzb[i].x));
        q.y = pk2(yb[db][4 * rg + 2] * bflo(zzb[i].y), yb[db][4 * rg + 3] * bfhi(zzb[i].y));
        *(u32x2*)(ypb + 8 * i) = q; }
}
DI float table_far(const float* tbl, int r) { return tbl[r * 464 + 63]; }
DI f32x16 cmp_qk(const char* lds, int st, int lane, const bf16x8 (&qf)[4]) {
    f32x16 s;
#pragma unroll
    for (int i = 0; i < 16; ++i) s[i] = 0.f;
    const int row = st * 32 + (lane & 31), h = lane >> 5; const char* kp = lds + row * 128; const int sw = (row >> 1) & 7;
#pragma unroll
    for (int ks = 0; ks < 4; ++ks) { const bf16x8 kf = *(const bf16x8*)(kp + (((2 * ks + h) ^ sw) << 4)); s = mfma32(kf, qf[ks], s); }
    return s;
}

DI void unit(const Params& p, bool isB, int bg, int qb, char* lds) {
    int tid_ = threadIdx.x; asm volatile("" : "+v"(tid_));
    const int tid = tid_, lane = tid & 63, w = __builtin_amdgcn_readfirstlane(tid >> 6), b = bg >> 1, g = bg & 1, h = lane >> 5;
    const bf16_t* HM = (const bf16_t*)(p.ws + WS_HM); bf16_t* Y = (bf16_t*)(p.ws + WS_Y); const float* GB = (const float*)(p.ws + WS_GB);
    float* tbl0 = (float*)(lds + L4_TBL0); float* tbl1 = (float*)(lds + L4_TBL1); float* sc = (float*)(lds + L4_SC);
    float* wsc = (float*)(lds + L4_WSCR + w * 8448) + lane;
    const int t0 = isB ? qb * 256 : qb * 128, tq0 = t0 + 32 * (isB ? w : (w & 3)), tq = tq0 + (lane & 31), m = b * 4096 + tq;
    const int thi = (t0 + (isB ? 255 : 127)) >> 6;
    const bf16_t* Kc = (const bf16_t*)(p.ws + WS_KCMP) + (size_t)bg * 256 * 64;
    const bf16_t* Vc = (const bf16_t*)(p.ws + WS_VCMP) + (size_t)bg * 256 * 64;
    const int hic_t = (tq - 31) >> 4;
    const int ctmax = ((t0 + 224) >> 4) >> 6;
    const float* TG = (const float*)(p.ws + WS_TBL);
    const float ccmp = TG[3 * 8 * 464 + 24];
    unsigned mask_even = 0xffffffffu, mask_odd = 0xffffffffu;
    {
        const int k0_ = isB ? 1 : 0;
        if (tid < 464) { *(f32x4*)(tbl0 + 4 * tid) = *(const f32x4*)(TG + (k0_ * 8 + 4 * g) * 464 + 4 * tid);
            if (isB) *(f32x4*)(tbl1 + 4 * tid) = *(const f32x4*)(TG + (2 * 8 + 4 * g) * 464 + 4 * tid); }
        if (tid < 4) sc[tid] = TG[3 * 8 * 464 + k0_ * 8 + 4 * g + tid];
    }
    if (isB) {
        const int nst = ((tq0 >> 4) >> 5) + 1;
        for (int i = tid; i < (ctmax + 1) * 512; i += NTHREADS) { const int row = i >> 3, ch = i & 7;
            *(u32x4*)(lds + row * 128 + ((ch ^ ((row >> 1) & 7)) << 4)) = *(const u32x4*)(Kc + (size_t)i * 8); }
        for (int i = 0; i < 33; ++i) wsc[i * 64] = 0.f;
        __syncthreads();
        {
            const int hic_min = (tq0 - 31) >> 4;
            f32x16 cinc;
#pragma unroll
            for (int i = 0; i < 16; ++i) cinc[i] = ccmp;
#pragma unroll 1
            for (int r = 0; r < 4; ++r) {
                bf16x8 qf[4]; load_q(HM, 20 + 4 * g + r, m, lane, qf);
                float lsum = 0.f;
                float E[33];
#pragma unroll
                for (int i = 0; i < 33; ++i) E[i] = 0.f;
#pragma unroll
                for (int st = 0; st < 8; ++st) {
                    if (st < nst) {
                        f32x16 s = cinc;
                        { const int row = st * 32 + (lane & 31); const char* kp = lds + row * 128; const int sw = (row >> 1) & 7;
#pragma unroll
                          for (int ks = 0; ks < 4; ++ks) { const bf16x8 kf = *(const bf16x8*)(kp + (((2 * ks + h) ^ sw) << 4)); s = mfma32(kf, qf[ks], s); } }
                        if (st * 32 + 31 > hic_min) { const int H = hic_t - st * 32 - 4 * h;
#pragma unroll
                            for (int i = 0; i < 16; ++i) s[i] = ((i & 3) + 8 * (i >> 2) <= H) ? s[i] : -INFINITY; }
#pragma unroll
                        for (int q = 0; q < 4; ++q) {
                            const float e0 = ex2(s[4 * q]), e1 = ex2(s[4 * q + 1]), e2 = ex2(s[4 * q + 2]), e3 = ex2(s[4 * q + 3]);
                            lsum += (e0 + e1) + (e2 + e3);
                            const float half = 0.5f * e3;
                            const float recv = __shfl_xor(half, 32);
                            E[st * 4 + q] += (e0 + e1) + (e2 + half) + (h ? recv : 0.f);
                            E[st * 4 + q + 1] += (h ? 0.f : recv);
                        }
                    }
                }
                const float l = lsum + __shfl_xor(lsum, 32);
                const float inv = l > 0.f ? 1.f / l : 0.f;
#pragma unroll
                for (int i = 0; i < 33; ++i) wsc[i * 64] += E[i] * inv;
            }
        }
        const int cur = tq0 >> 6;
        if (cur >= 16) {
            unsigned* keyL = (unsigned*)wsc;
#pragma unroll 4
            for (int i = 0; i < 32; ++i) { const int j = 2 * i + h; const bool ok = (j >= 1) && (j <= cur - 2);
                const unsigned bits = __builtin_bit_cast(unsigned, wsc[i * 64]);
                keyL[i * 64] = ok ? ((bits & 0xffffffc0u) + 64u + (unsigned)(63 - j)) : 0u; }
            mask_even = 1u; mask_odd = 0u;
            if (cur & 1) { mask_odd |= 1u << (cur >> 1); mask_even |= 1u << ((cur - 1) >> 1); }
            else { mask_even |= 1u << (cur >> 1); mask_odd |= 1u << ((cur - 1) >> 1); }
#pragma unroll 1
            for (int it = 0; it < 13; ++it) {
                unsigned mx = 0u;
#pragma unroll 8
                for (int i = 0; i < 32; ++i) { const unsigned k = keyL[i * 64]; mx = mx > k ? mx : k; }
                const unsigned mo = (unsigned)__shfl_xor((int)mx, 32); mx = mx > mo ? mx : mo;
                const int j = 63 - (int)(mx & 63u);
                if ((j & 1) == h) keyL[(j >> 1) * 64] = 0u;
                if (j & 1) mask_odd |= 1u << (j >> 1); else mask_even |= 1u << (j >> 1);
            }
        }
    }
    __syncthreads();
    const int nbr = isB ? 3 : 1;
    int lo0, hi0, lo1 = 0, hi1 = 0, lo2 = 0, hi2 = 0;
    const bf16_t *Kb0, *Vb0, *Kb1 = nullptr, *Vb1 = nullptr, *Kb2 = nullptr, *Vb2 = nullptr;
    if (!isB) { lo0 = (t0 - 128) < 0 ? 0 : ((t0 - 128) >> 6); hi0 = thi;
        Kb0 = HM + ((size_t)(8 + g) * M + (size_t)b * 4096) * 64; Vb0 = HM + ((size_t)(10 + g) * M + (size_t)b * 4096) * 64; }
    else { lo0 = 0; hi0 = ctmax; lo1 = 0; hi1 = thi; lo2 = (t0 - 512) < 0 ? 0 : ((t0 - 512) >> 6); hi2 = thi;
        Kb0 = Kc; Vb0 = Vc;
        Kb1 = HM + ((size_t)(32 + g) * M + (size_t)b * 4096) * 64; Vb1 = HM + ((size_t)(34 + g) * M + (size_t)b * 4096) * 64;
        Kb2 = HM + ((size_t)(36 + g) * M + (size_t)b * 4096) * 64; Vb2 = HM + ((size_t)(38 + g) * M + (size_t)b * 4096) * 64; }
    int l_it = 0, l_br = 0, l_tile = lo0, k_issued = 0, kidx = 0;
    const int n_it = isB ? 2 * nbr : 1;
    const int drow = 8 * w + (lane >> 3), dpc = lane & 7;
    const int koff = drow * 64 + ((dpc ^ ((drow >> 1) & 7)) << 3);
    const int voff = drow * 64 + ((dpc ^ (((drow >> 1) & 1) << 2)) << 3);
    LaneC lc;
    { const int kr = lane & 31, i16 = lane & 15, q4 = i16 >> 2, p4 = i16 & 3, g16 = (lane >> 4) & 1, vsw = ((q4 >> 1) & 1) << 3, cb = 4 * g16 + p4;
      lc.kA = kr * 128 + ((h ^ ((kr >> 1) & 7)) << 4);
      lc.vA0 = (4 * h + q4) * 128 + ((cb ^ vsw) << 3); lc.vA1 = (4 * h + q4) * 128 + (((8 + cb) ^ vsw) << 3);
      lc.Xc = 191 - tq + 4 * h; lc.h4 = 4 * h; }
#define ISSUE_INTERVAL() do { if (l_it < n_it) { \
        const bf16_t* kb_ = l_br == 0 ? Kb0 : (l_br == 1 ? Kb1 : Kb2); const bf16_t* vb_ = l_br == 0 ? Vb0 : (l_br == 1 ? Vb1 : Vb2); \
        const int lhi_ = l_br == 0 ? hi0 : (l_br == 1 ? hi1 : hi2); \
        LAS unsigned* dst_ = (LAS unsigned*)(lds + (k_issued & 1) * 32768 + w * 1024); \
        __builtin_amdgcn_global_load_lds((const unsigned*)(kb_ + (size_t)l_tile * 4096 + koff), dst_, 16, 0, 0); \
        __builtin_amdgcn_global_load_lds((const unsigned*)(vb_ + (size_t)l_tile * 4096 + voff), dst_ + 2048, 16, 0, 0); \
        if (l_tile < lhi_) { \
            __builtin_amdgcn_global_load_lds((const unsigned*)(kb_ + (size_t)(l_tile + 1) * 4096 + koff), dst_ + 4096, 16, 0, 0); \
            __builtin_amdgcn_global_load_lds((const unsigned*)(vb_ + (size_t)(l_tile + 1) * 4096 + voff), dst_ + 6144, 16, 0, 0); } \
        l_tile += 2; \
        if (l_tile > lhi_) { ++l_it; l_br = (l_br + 1 == nbr) ? 0 : l_br + 1; l_tile = l_br == 0 ? lo0 : (l_br == 1 ? lo1 : lo2); } } \
        ++k_issued; } while (0)
    ISSUE_INTERVAL();
    bf16x8 qfa[4], qfb[4];
    unsigned* wpk = (unsigned*)wsc;
#pragma unroll 1
    for (int it = 0; it < n_it; ++it) {
        const int hp = isB ? it / 3 : (w >> 2), br = isB ? it - 3 * hp : 0, rA = 2 * hp, rB = 2 * hp + 1;
        const int mode = isB ? br + 1 : 0;
        if (br == 0) { load_q(HM, (isB ? 20 : 0) + 4 * g + rA, m, lane, qfa); load_q(HM, (isB ? 20 : 0) + 4 * g + rB, m, lane, qfb); }
        const int tlo = __builtin_amdgcn_readfirstlane(br == 0 ? lo0 : (br == 1 ? lo1 : lo2)), th = __builtin_amdgcn_readfirstlane(br == 0 ? hi0 : (br == 1 ? hi1 : hi2));
        int hi_t = tq, lo_t = 0; bool bias = true, sel = false, scaled = true;
        int tboffA = L4_TBL0 + rA * 1856, tboffB = L4_TBL0 + rB * 1856; WB wb; wb.hi_min = tq0; wb.hi_max = tq0 + 31; wb.lo_min = 0; wb.lo_max = 0;
        float gateA = 1.f, gateB = 1.f, ccom = 0.f, fA = 1.f, fB = 1.f;
        if (mode == 0) { lo_t = tq - 127; wb.lo_min = tq0 - 127; wb.lo_max = tq0 + 31 - 127; }
        else if (mode == 1) { hi_t = hic_t; bias = false; wb.hi_min = (tq0 - 31) >> 4; wb.hi_max = tq0 >> 4; ccom = ccmp; }
        else if (mode == 2) { sel = true; scaled = false; ccom = TG[3 * 8 * 464 + 25 + 1]; fA = ex2(table_far(tbl0, rA) - ccom); fB = ex2(table_far(tbl0, rB) - ccom); }
        else { tboffA = L4_TBL1 + rA * 1856; tboffB = L4_TBL1 + rB * 1856; scaled = false; ccom = TG[3 * 8 * 464 + 25 + 2];
            fA = ex2(table_far(tbl1, rA) - ccom); fB = ex2(table_far(tbl1, rB) - ccom);
            lo_t = tq - 511; wb.lo_min = tq0 - 511; wb.lo_max = tq0 + 31 - 511; }
        if (isB) { gateA = GB[(size_t)m * 24 + (4 * g + rA) * 3 + br]; gateB = GB[(size_t)m * 24 + (4 * g + rB) * 3 + br]; }
        f32x16 OA[2], OB[2], cin;
#pragma unroll
        for (int i = 0; i < 16; ++i) { OA[0][i] = 0.f; OA[1][i] = 0.f; OB[0][i] = 0.f; OB[1][i] = 0.f; cin[i] = ccom; }
        float lA = 0.f, lB = 0.f;
#pragma unroll 1
        for (int tile0 = tlo; tile0 <= th; tile0 += 2) {
            asm volatile("s_waitcnt vmcnt(0)" ::: "memory");
            __builtin_amdgcn_s_barrier();
            asm volatile("" ::: "memory");
            ISSUE_INTERVAL();
            const int sbase = (kidx & 1) * 32768;
            ++kidx;
#pragma unroll 1
            for (int tt = 0; tt < 2; ++tt) {
                const int tile = tile0 + tt;
                if (tile > th) break;
                const int stoff = sbase + tt * 16384;
                float selterm = 0.f; bool any = true;
                if (sel) { const unsigned mk = (tile & 1) ? mask_odd : mask_even; const bool bit = (mk >> (tile >> 1)) & 1u;
                    selterm = bit ? 0.f : -INFINITY; any = __ballot(bit) != 0ull;
                    if (any) { const float cv = bit ? ccom : -INFINITY;
#pragma unroll
                        for (int i = 0; i < 16; ++i) cin[i] = cv; } }
                if (any) {
#pragma unroll
                    for (int sub = 0; sub < 2; ++sub) {
                        const int k0 = tile * 64 + sub * 32;
                        if (k0 > wb.hi_max || k0 + 31 < wb.lo_min) continue;
                        const bool need_hi = k0 + 31 > wb.hi_min, need_lo = k0 < wb.lo_max;
                        const bool use_tbl = bias && (tq0 - (k0 + 31) < 128);
                        if (use_tbl && !scaled) {
                            scaled = true;
#pragma unroll
                            for (int i = 0; i < 16; ++i) { OA[0][i] *= fA; OA[1][i] *= fA; OB[0][i] *= fB; OB[1][i] *= fB; }
                            lA *= fA; lB *= fB; }
                        subtile2_pv(lds, stoff + sub * 4096, k0, lc, qfa, qfb, OA, OB, lA, lB, cin, selterm, use_tbl, tboffA, tboffB, need_hi, hi_t, need_lo, lo_t);
                    }
                }
            }
        }
        if (!scaled) { lA *= fA; lB *= fB;
#pragma unroll
            for (int i = 0; i < 16; ++i) { OA[0][i] *= fA; OA[1][i] *= fA; OB[0][i] *= fB; OB[1][i] *= fB; } }
        float la = lA + __shfl_xor(lA, 32), lb = lB + __shfl_xor(lB, 32);
        if (mode == 0) { la += ex2((p.sinks[4 * g + rA] - sc[rA]) * LOG2E); lb += ex2((p.sinks[4 * g + rB] - sc[rB]) * LOG2E); }
        const float sa_ = (la > 0.f ? 1.f / la : 0.f) * gateA, sb_ = (lb > 0.f ? 1.f / lb : 0.f) * gateB;
#pragma unroll
        for (int i = 0; i < 16; ++i) { OA[0][i] *= sa_; OA[1][i] *= sa_; OB[0][i] *= sb_; OB[1][i] *= sb_; }
        if (br != 0) {
#pragma unroll
            for (int i = 0; i < 8; ++i) { const unsigned u0 = wpk[i * 64], u1 = wpk[(8 + i) * 64], v0 = wpk[(16 + i) * 64], v1 = wpk[(24 + i) * 64];
                OA[0][2 * i] += bflo(u0); OA[0][2 * i + 1] += bfhi(u0); OA[1][2 * i] += bflo(u1); OA[1][2 * i + 1] += bfhi(u1);
                OB[0][2 * i] += bflo(v0); OB[0][2 * i + 1] += bfhi(v0); OB[1][2 * i] += bflo(v1); OB[1][2 * i + 1] += bfhi(v1); }
        }
        if (br == nbr - 1) {
            write_y2(Y, HM, (isB ? 40 : 12) + 4 * g + rA, (isB ? 40 : 12) + 4 * g + rB, m, (isB ? 512 : 0) + (4 * g + rA) * 64, (isB ? 512 : 0) + (4 * g + rB) * 64, lane, OA, OB);
        } else {
#pragma unroll
            for (int i = 0; i < 8; ++i) { wpk[i * 64] = pk2(OA[0][2 * i], OA[0][2 * i + 1]); wpk[(8 + i) * 64] = pk2(OA[1][2 * i], OA[1][2 * i + 1]);
                wpk[(16 + i) * 64] = pk2(OB[0][2 * i], OB[0][2 * i + 1]); wpk[(24 + i) * 64] = pk2(OB[1][2 * i], OB[1][2 * i + 1]); }
        }
    }
#undef ISSUE_INTERVAL
    asm volatile("s_waitcnt vmcnt(0)" ::: "memory");
    __syncthreads();
}

DI void phase4(const Params& p, char* lds) {
    unsigned* ctr = (unsigned*)(p.ws + WS_CTL);
    volatile int* su = (volatile int*)(lds + L4_UNIT);
    for (;;) {
        if (threadIdx.x == 0) *su = (int)atomicAdd(ctr, 1u);
        __syncthreads();
        const int u = __builtin_amdgcn_readfirstlane(*su);
        __syncthreads();
        if (u >= 1536) break;
        const bool isB = u < 512; const int uu = isB ? u : u - 512;
        unit(p, isB, uu & 31, (isB ? 15 : 31) - (uu >> 5), lds);
    }
}

__global__ void __launch_bounds__(NTHREADS, 2) fwd_kernel(Params p) {
    extern __shared__ __attribute__((aligned(16))) char lds[];
    const int lo = p.ph_lo, hi = p.ph_hi;
    volatile LAS unsigned* misc = (volatile LAS unsigned*)(LAS char*)(lds + LDS_MISC);
    if (threadIdx.x < 16) misc[threadIdx.x] = 0u;
    __syncthreads();
    XcdBarrier bar = xcd_barrier_post((unsigned*)(p.ws + WS_CTL) + 1024, misc);
#define IN(k) (lo <= (k) && (k) < hi)
#define SEAM(k) do { if (IN((k) + 1)) xcd_barrier(bar); } while (0)
    if (IN(0)) { phase0(p, lds); SEAM(0); }
    if (IN(1)) { phase1(p, lds); SEAM(1); }
    if (IN(2)) {
        pg8::Gemm gm{(const bf16_t*)(p.ws + WS_H), (const bf16_t*)(p.ws + WS_WINT), M, NPADW, 1024};
        pg8::StaticOrder S; S.init(M, NPADW, (int)gridDim.x, (int)blockIdx.x);
        { const int t = threadIdx.x;
          if (t < 320) { const float* gsrc = t < 64 ? p.q_gain_a : t < 128 ? p.k_gain_a : t < 192 ? p.q_gain_b : t < 256 ? p.k_gain_sel : p.k_gain_win;
              ((float*)(lds + 131072))[t] = gsrc[t & 63]; }
          __syncthreads(); }
        EpiIn E{(bf16_t*)(p.ws + WS_HM), (const LAS float*)(lds + 131072)};
        pg8::gemm_phase<EpiIn, pg8::StaticOrder, GEMM_ALIGN, GEMM_SP2>((LAS unsigned char*)lds, gm, S, E);
        SEAM(2);
    }
    if (IN(3)) { phase3(p, lds); SEAM(3); }
    if (IN(4)) { phase4(p, lds); SEAM(4); }
    if (IN(5)) {
        pg8::Gemm gm{(const bf16_t*)(p.ws + WS_Y), (const bf16_t*)(p.ws + WS_WOUTT), M, 1024, 1024};
        pg8::StaticOrder S; S.init(M, 1024, (int)gridDim.x, (int)blockIdx.x);
        EpiOut E{p.x, (const float*)(p.ws + WS_MOD), p.out};
        pg8::gemm_phase<EpiOut, pg8::StaticOrder, GEMM_ALIGN, GEMM_SP2>((LAS unsigned char*)lds, gm, S, E);
    }
#undef IN
#undef SEAM
}

extern "C" void kernel_launch(void* const* d_in, const int* in_sizes, int n_in, void* d_out, int out_size, void* d_ws, size_t ws_size, hipStream_t stream) {
    static int grid = 0;
    if (grid == 0) {
        if (n_in != 22 || out_size != M * DM || ws_size < WS_END) { fprintf(stderr, "kernel_launch: unexpected shapes (n_in %d out %d ws %zu need %zu)\n", n_in, out_size, ws_size, (size_t)WS_END); grid = -1; return; }
        int dev = 0, cus = 0, per_cu = 0;
        (void)hipGetDevice(&dev); (void)hipDeviceGetAttribute(&cus, hipDeviceAttributeMultiprocessorCount, dev);
        (void)hipFuncSetAttribute((const void*)fwd_kernel, hipFuncAttributeMaxDynamicSharedMemorySize, LDS_BYTES);
        (void)hipOccupancyMaxActiveBlocksPerMultiprocessor(&per_cu, (const void*)fwd_kernel, NTHREADS, LDS_BYTES);
        if (per_cu < 1) { fprintf(stderr, "kernel_launch: occupancy query says %d blocks/CU\n", per_cu); grid = -1; return; }
        grid = cus;
        fprintf(stderr, "kernel_launch: cus %d per_cu %d grid %d\n", cus, per_cu, grid);
    }
    if (grid < 0) return;
    (void)hipMemsetAsync((char*)d_ws + WS_CTL, 0, CTL_BYTES, stream);
    Params p{};
    const float** pin = (const float**)&p;
    for (int i = 0; i < 22; ++i) pin[i] = (const float*)d_in[i];
    p.out = (float*)d_out; p.ws = (unsigned char*)d_ws;
#if N_LAUNCHES == 1
    p.ph_lo = 0; p.ph_hi = 6;
    void* args[] = {&p};
    hipError_t e = hipLaunchCooperativeKernel((const void*)fwd_kernel, dim3(grid), dim3(NTHREADS), args, LDS_BYTES, stream);
    if (e != hipSuccess) fprintf(stderr, "cooperative launch failed: %s (grid %d)\n", hipGetErrorString(e), grid);
#else
    for (int ph = 0; ph < 6; ++ph) { p.ph_lo = ph; p.ph_hi = ph + 1; hipLaunchKernelGGL(fwd_kernel, dim3(grid), dim3(NTHREADS), LDS_BYTES, stream, p); }
#endif
}
```

```cpp
#include <hip/hip_runtime.h>
#include <cstdio>
#include <cstdint>

#ifndef GEMM_ALIGN
#define GEMM_ALIGN true
#endif
#ifndef GEMM_SP2
#define GEMM_SP2 true
#endif
#ifndef N_LAUNCHES
#define N_LAUNCHES 1
#endif

#define DI __device__ __forceinline__
#define LAS __attribute__((address_space(3)))
typedef unsigned short bf16_t;
typedef short bf16x8 __attribute__((ext_vector_type(8)));
typedef short s16x4 __attribute__((ext_vector_type(4)));
typedef float f32x2 __attribute__((ext_vector_type(2)));
typedef float f32x4 __attribute__((ext_vector_type(4)));
typedef float f32x16 __attribute__((ext_vector_type(16)));
typedef unsigned u32x2 __attribute__((ext_vector_type(2)));
typedef unsigned u32x4 __attribute__((ext_vector_type(4)));
typedef __bf16 bf16x2v __attribute__((ext_vector_type(2)));

constexpr int NBATCH = 16, SEQ = 4096, M = NBATCH * SEQ, DM = 1024, NPROJ = 3096, NPADW = 3072;
constexpr float EPS = 1e-6f, LOG2E = 1.4426950408889634f;
constexpr size_t MiB = 1u << 20;
constexpr size_t WS_CTL = 0;
constexpr size_t CTL_BYTES = 32768;
constexpr size_t WS_MOD = 1 * MiB;
constexpr size_t WS_BIAS1 = WS_MOD + 256 * 1024;
constexpr size_t WS_TBL = WS_MOD + 512 * 1024;
constexpr size_t WS_W2T = 2 * MiB;
constexpr size_t WS_W1T = 3 * MiB;
constexpr size_t WS_WOUTT = 5 * MiB;
constexpr size_t WS_WINT = 7 * MiB;
constexpr size_t WS_KCMP = 14 * MiB;
constexpr size_t WS_VCMP = 15 * MiB;
constexpr size_t WS_GB = 16 * MiB;
constexpr size_t WS_H = 32 * MiB;
constexpr size_t WS_Y = 160 * MiB;
constexpr size_t WS_HM = 288 * MiB;
constexpr size_t WS_END = WS_HM + (size_t)48 * M * 64 * 2;
constexpr int LDS_BYTES = 148992;
constexpr int LDS_MISC = 148480;
constexpr int NTHREADS = 512;

struct Params {
    const float *x, *c, *w_ada, *b_ada, *norm_gain, *w_in, *b_gate, *q_gain_a, *k_gain_a, *sinks, *q_gain_b,
        *k_gain_cmp, *k_gain_sel, *k_gain_win, *cmp_pos_k, *cmp_pos_v, *w_cmp_k1, *w_cmp_k2, *w_cmp_v1, *w_cmp_v2, *w_out, *rel_bias;
    float* out; unsigned char* ws; int ph_lo, ph_hi;
};

DI unsigned pk2(float lo, float hi) { f32x2 v = {lo, hi}; bf16x2v b = __builtin_convertvector(v, bf16x2v); return __builtin_bit_cast(unsigned, b); }
DI float bflo(unsigned u) { return __builtin_bit_cast(float, u << 16); }
DI float bfhi(unsigned u) { return __builtin_bit_cast(float, u & 0xffff0000u); }
DI float ex2(float x) { return __builtin_amdgcn_exp2f(x); }
DI float rsq(float x) { return __builtin_amdgcn_rsqf(x); }
DI float sigm(float x) { return __builtin_amdgcn_rcpf(1.f + __builtin_amdgcn_exp2f(x * -LOG2E)); }
DI float wave_sum(float v) {
#pragma unroll
    for (int o = 1; o < 64; o <<= 1) v += __shfl_xor(v, o);
    return v;
}
DI f32x4 mfma16(bf16x8 a, bf16x8 b, f32x4 c) { return __builtin_amdgcn_mfma_f32_16x16x32_bf16(a, b, c, 0, 0, 0); }
DI f32x16 mfma32(bf16x8 a, bf16x8 b, f32x16 c) { return __builtin_amdgcn_mfma_f32_32x32x16_bf16(a, b, c, 0, 0, 0); }
DI int t5_bucket(int n) {
    if (n < 16) return n < 0 ? 0 : n;
    int b = 16;
    b += (n >= 19); b += (n >= 21); b += (n >= 24); b += (n >= 27); b += (n >= 31); b += (n >= 35); b += (n >= 40); b += (n >= 46);
    b += (n >= 52); b += (n >= 59); b += (n >= 67); b += (n >= 77); b += (n >= 87); b += (n >= 99); b += (n >= 113);
    return b;
}

#define XB_TMO      128
#define XB_XCNT(j)  (256  + 64 * (j))
#define XB_XSUB(j)  (1280 + 64 * (j))
#define XB_XGEN(j)  (2304 + 64 * (j))
#define XB_TOP      3328
#define XB_TOPGEN   3392
#define XCD_BAR_WORDS 3456
#define XB_SPIN_CAP (1u << 18)
DI unsigned xb_ld(unsigned* p)              { return __hip_atomic_load(p, __ATOMIC_RELAXED, __HIP_MEMORY_SCOPE_AGENT); }
DI unsigned xb_add(unsigned* p, unsigned v) { return __hip_atomic_fetch_add(p, v, __ATOMIC_RELAXED, __HIP_MEMORY_SCOPE_AGENT); }
DI unsigned xb_xcc_id() { return (unsigned)__builtin_amdgcn_s_getreg((3 << 11) | 20) & 0xFu; }
#define XB_SPIN(cond, bar) do { unsigned _sp = 0; while (cond) { __builtin_amdgcn_s_sleep(1); \
    if ((++_sp & 255u) == 0u) { if (xb_ld(&(bar)[XB_TMO])) break; if (_sp > XB_SPIN_CAP) { atomicAdd(&(bar)[XB_TMO], 1u); break; } } } } while (0)
struct XcdBarrier { unsigned* bar; unsigned x; volatile LAS unsigned* st; };
DI XcdBarrier xcd_barrier_post(unsigned* bar, volatile LAS unsigned* st) {
    XcdBarrier b; b.bar = bar; b.x = xb_xcc_id(); b.st = st;
    if (threadIdx.x == 0) (void)xb_add(&bar[XB_XCNT(b.x)], 1u);
    return b;
}
DI void xcd_barrier_complete(unsigned* bar, unsigned x, unsigned& nloc, unsigned& nx) {
    const unsigned G = gridDim.x * gridDim.y * gridDim.z;
    unsigned sum, cnt, mine, sp = 0u;
    for (;;) {
        sum = 0u; cnt = 0u; mine = 0u;
#pragma unroll
        for (unsigned j = 0; j < 16; ++j) { const unsigned c = xb_ld(&bar[XB_XCNT(j)]); sum += c; cnt += (c > 0u) ? 1u : 0u; mine = (j == x) ? c : mine; }
        if (sum == G) break;
        __builtin_amdgcn_s_sleep(1);
        if ((++sp & 255u) == 0u) { if (xb_ld(&bar[XB_TMO])) break; if (sp > XB_SPIN_CAP) { atomicAdd(&bar[XB_TMO], 1u); break; } }
    }
    nloc = mine > 0u ? mine : 1u; nx = cnt > 0u ? cnt : 1u;
}
DI void xcd_barrier(const XcdBarrier& b) {
    asm volatile("s_waitcnt vmcnt(0)" ::: "memory");
    __syncthreads();
    if (threadIdx.x == 0) {
        unsigned* bar = b.bar;
        __builtin_amdgcn_s_waitcnt(0);
        unsigned nloc = b.st[0], nx = b.st[1];
        if (nloc == 0u) { xcd_barrier_complete(bar, b.x, nloc, nx); b.st[0] = nloc; b.st[1] = nx; }
        const unsigned old = xb_add(&bar[XB_XSUB(b.x)], 1u);
        const unsigned gen = old / nloc;
        if (old + 1u == (gen + 1u) * nloc) {
            __builtin_amdgcn_fence(__ATOMIC_RELEASE, "agent");
            asm volatile("s_waitcnt vmcnt(0)" ::: "memory");
            const unsigned og = xb_add(&bar[XB_TOP], 1u);
            const unsigned tg = og / nx;
            if (og + 1u == (tg + 1u) * nx) xb_add(&bar[XB_TOPGEN], 1u);
            else XB_SPIN(xb_ld(&bar[XB_TOPGEN]) == tg, bar);
            __builtin_amdgcn_fence(__ATOMIC_ACQUIRE, "agent");
            xb_add(&bar[XB_XGEN(b.x)], 1u);
            asm volatile("s_waitcnt vmcnt(0)" ::: "memory");
        } else {
            XB_SPIN(xb_ld(&bar[XB_XGEN(b.x)]) == gen, bar);
            __builtin_amdgcn_fence(__ATOMIC_ACQUIRE, "agent");
            asm volatile("s_waitcnt vmcnt(0)" ::: "memory");
        }
    }
    __syncthreads();
}

namespace pg8 {
constexpr int BM = 256, BK = 64, HALF = 128, HTB = HALF * BK * 2, STAGE_BYTES = 8 * HTB, NXCD = 8, WGM = 8;
__host__ __device__ __forceinline__ int lds_byte(int r, int c) { const int st = (r >> 4) * 2 + (c >> 5), rr = r & 15, cc = c & 31, ob = rr * 64 + cc * 2; return st * 1024 + (ob ^ (((ob >> 9) & 1) << 5)); }
__host__ __device__ __forceinline__ void stage_rc(int b, int& R, int& C) { const int st = b / 1024, sb = b % 1024, swz = sb ^ (((sb >> 9) & 1) << 5); R = (st >> 1) * 16 + swz / 64; C = (st & 1) * 32 + (swz % 64) / 2; }
__host__ __device__ __forceinline__ int perm32(int rho) { const int n = rho >> 4, i = rho & 15; return 8 * (i >> 2) + 4 * n + (i & 3); }
struct Unit { int pm, pn; };
struct Gemm { const bf16_t* A; const bf16_t* Bt; int M, N, K; };
struct StaticOrder {
    int nM, nN, nwg, G, c;
    __host__ __device__ void init(int M_, int N_, int G_, int c_) { nM = M_ / BM; nN = N_ / BM; nwg = nM * nN; G = G_; c = c_; }
    __host__ __device__ bool next(int i, Unit& u) const {
        const long L = (long)i * G + c; if (L >= nwg) return false;
        int wgid = (int)L; { const int q = nwg / NXCD, r = nwg % NXCD, xcd = wgid % NXCD, off = wgid / NXCD; wgid = (xcd < r ? xcd * (q + 1) : r * (q + 1) + (xcd - r) * q) + off; }
        const int nig = WGM * nN, gid = wgid / nig, fm = gid * WGM, gsz = (nM - fm) < WGM ? (nM - fm) : WGM;
        u.pm = fm + ((wgid % nig) % gsz); u.pn = (wgid % nig) / gsz; return true;
    }
};
template <class Epi, class Sched, bool ALIGN_EPI, bool SP2>
__device__ __forceinline__ void gemm_phase(LAS unsigned char* lds, const Gemm g, const Sched& S, const Epi& E) {
    const int tid = threadIdx.x, wid = __builtin_amdgcn_readfirstlane(tid >> 6), lane = tid & 63, wr = wid >> 2, wc = wid & 3, fr = lane & 15, fq = lane >> 4;
    const int K = g.K, nt = K / BK;
    unsigned voffA[2], voffB[2];
#pragma unroll
    for (int i = 0; i < 2; ++i) { int R, C; stage_rc(tid * 16 + i * 8192, R, C); const int Rb = Epi::brow(R);
        voffA[i] = (unsigned)(R * K + C) * 2u; voffB[i] = (unsigned)(Rb * K + C) * 2u; }
    const size_t kstep = (size_t)(BK * 2);
    const size_t hstep = (size_t)HALF * K * 2;
    const size_t hstepB = (size_t)Epi::BHALF * K * 2;
    const size_t tstep = 2 * hstep;
    const unsigned ldsw = (unsigned)wid * 1024u;
    const int aoff = lds_byte(wr * 64 + fr, fq * 8), boff = lds_byte(wc * 32 + fr, fq * 8);
#define PG8_SA(b, h) (((b) * 2 + (h)) * HTB)
#define PG8_SB(b, h) ((4 + (b) * 2 + (h)) * HTB)
#define PG8_STAGE(bufoff, gbase, voff) do { _Pragma("unroll") for (int _i = 0; _i < 2; ++_i) \
        __builtin_amdgcn_global_load_lds((const unsigned*)((const char*)(gbase) + (voff)[_i]), (LAS unsigned*)(lds + (bufoff) + ldsw + _i * 8192), 16, 0, 0); } while (0)
#define PG8_LDA(dst, b, h) do { _Pragma("unroll") for (int m = 0; m < 4; ++m) _Pragma("unroll") for (int k = 0; k < 2; ++k) dst[m][k] = *(const LAS bf16x8*)(lds + PG8_SA(b, h) + aoff + m * 2048 + k * 1024); } while (0)
#define PG8_LDB(dst, b, h) do { _Pragma("unroll") for (int n = 0; n < 2; ++n) _Pragma("unroll") for (int k = 0; k < 2; ++k) dst[n][k] = *(const LAS bf16x8*)(lds + PG8_SB(b, h) + boff + n * 2048 + k * 1024); } while (0)
#define PG8_MMA(ai, bj, At, Bt) do { __builtin_amdgcn_s_setprio(1); _Pragma("unroll") for (int m = 0; m < 4; ++m) _Pragma("unroll") for (int n = 0; n < 2; ++n) _Pragma("unroll") for (int k = 0; k < 2; ++k) \
        acc[ai][bj][m][n] = __builtin_amdgcn_mfma_f32_16x16x32_bf16(Bt[n][k], At[m][k], acc[ai][bj][m][n], 0, 0, 0); __builtin_amdgcn_s_setprio(0); } while (0)
#define PG8_WAIT_V(n) asm volatile("s_waitcnt vmcnt(" #n ")" ::: "memory")
#define PG8_WAIT_L(n) asm volatile("s_waitcnt lgkmcnt(" #n ")" ::: "memory")
#define PG8_BAR __builtin_amdgcn_s_barrier()
#define PG8_SCHED __builtin_amdgcn_sched_barrier(0)
    Unit cur, nxt; int ui = 0;
    if (!S.next(0, cur)) return;
    f32x4 acc[2][2][4][2];
#pragma unroll
    for (int a = 0; a < 2; ++a)
#pragma unroll
        for (int b = 0; b < 2; ++b)
#pragma unroll
            for (int m = 0; m < 4; ++m)
#pragma unroll
                for (int n = 0; n < 2; ++n) acc[a][b][m][n] = (f32x4){0.f, 0.f, 0.f, 0.f};
    bf16x8 At[4][2], B0[2][2], B1[2][2];
    const char* cA = (const char*)g.A + (size_t)cur.pm * tstep; const char* cB = (const char*)g.Bt + (size_t)cur.pn * tstep;
    if constexpr (SP2) {
        PG8_STAGE(PG8_SB(0, 0), cB, voffB); PG8_STAGE(PG8_SB(0, 1), cB + hstepB, voffB); PG8_STAGE(PG8_SA(0, 0), cA, voffA); PG8_STAGE(PG8_SA(0, 1), cA + hstep, voffA);
        if (wr == 1) PG8_BAR;
        PG8_WAIT_V(2); PG8_BAR;
        PG8_STAGE(PG8_SB(1, 0), cB + kstep, voffB); PG8_STAGE(PG8_SA(1, 0), cA + kstep, voffA); PG8_STAGE(PG8_SB(1, 1), cB + hstepB + kstep, voffB);
        PG8_WAIT_V(6); PG8_BAR;
    } else {
        PG8_STAGE(PG8_SB(0, 0), cB, voffB); PG8_STAGE(PG8_SA(0, 0), cA, voffA); PG8_STAGE(PG8_SB(0, 1), cB + hstepB, voffB); PG8_STAGE(PG8_SA(0, 1), cA + hstep, voffA);
        if (wr == 1) PG8_BAR;
        PG8_WAIT_V(4); PG8_BAR;
        PG8_STAGE(PG8_SB(1, 0), cB + kstep, voffB); PG8_STAGE(PG8_SA(1, 0), cA + kstep, voffA); PG8_STAGE(PG8_SB(1, 1), cB + hstepB + kstep, voffB);
        PG8_WAIT_V(6); PG8_BAR;
    }
    for (;;) {
        const bool has_next = S.next(ui + 1, nxt);
        const char* nA = has_next ? (const char*)g.A + (size_t)nxt.pm * tstep : cA; const char* nB = has_next ? (const char*)g.Bt + (size_t)nxt.pn * tstep : cB;
        for (int t = 0; t < nt; t += 2) {
            const bool last = (t == nt - 2);
            const char* a1 = cA + (size_t)(t + 1) * kstep;
            const char* a2 = last ? nA : cA + (size_t)(t + 2) * kstep; const char* b2 = last ? nB : cB + (size_t)(t + 2) * kstep;
            const char* a3 = a2 + kstep; const char* b3 = b2 + kstep;
            if constexpr (SP2) {
            PG8_LDB(B0, 0, 0); PG8_LDB(B1, 0, 1); PG8_SCHED; PG8_LDA(At, 0, 0); PG8_STAGE(PG8_SA(1, 1), a1 + hstep, voffA);
            PG8_WAIT_V(8); PG8_WAIT_L(0); PG8_BAR; PG8_MMA(0, 0, At, B0); PG8_MMA(0, 1, At, B1); PG8_BAR; PG8_SCHED;
            PG8_LDA(At, 0, 1); PG8_STAGE(PG8_SB(0, 0), b2, voffB); PG8_STAGE(PG8_SB(0, 1), b2 + hstepB, voffB); PG8_STAGE(PG8_SA(0, 0), a2, voffA);
            PG8_WAIT_V(8); PG8_WAIT_L(0); PG8_BAR; PG8_MMA(1, 0, At, B0); PG8_MMA(1, 1, At, B1); PG8_BAR; PG8_SCHED;
            PG8_LDB(B0, 1, 0); PG8_LDB(B1, 1, 1); PG8_SCHED; PG8_LDA(At, 1, 0); PG8_STAGE(PG8_SA(0, 1), a2 + hstep, voffA);
            PG8_WAIT_V(8); PG8_WAIT_L(0); PG8_BAR; PG8_MMA(0, 0, At, B0); PG8_MMA(0, 1, At, B1); PG8_BAR; PG8_SCHED;
            PG8_LDA(At, 1, 1); PG8_STAGE(PG8_SB(1, 0), b3, voffB); PG8_STAGE(PG8_SB(1, 1), b3 + hstepB, voffB); PG8_STAGE(PG8_SA(1, 0), a3, voffA);
            PG8_WAIT_V(8); PG8_WAIT_L(0); PG8_BAR; PG8_MMA(1, 0, At, B0); PG8_MMA(1, 1, At, B1); PG8_BAR; PG8_SCHED;
            } else {
            PG8_LDB(B0, 0, 0); PG8_SCHED; PG8_LDA(At, 0, 0); PG8_STAGE(PG8_SA(1, 1), a1 + hstep, voffA);
            PG8_WAIT_L(8); PG8_BAR; PG8_WAIT_L(0); PG8_MMA(0, 0, At, B0); PG8_BAR; PG8_SCHED;
            PG8_LDB(B1, 0, 1); PG8_STAGE(PG8_SB(0, 0), b2, voffB);
            PG8_BAR; PG8_WAIT_L(0); PG8_MMA(0, 1, At, B1); PG8_BAR;
            PG8_LDA(At, 0, 1); PG8_STAGE(PG8_SA(0, 0), a2, voffA);
            PG8_BAR; PG8_WAIT_L(0); PG8_MMA(1, 0, At, B0); PG8_BAR; PG8_SCHED;
            PG8_STAGE(PG8_SB(0, 1), b2 + hstepB, voffB);
            PG8_WAIT_V(6); PG8_BAR; PG8_MMA(1, 1, At, B1); PG8_BAR;
            PG8_LDB(B0, 1, 0); PG8_SCHED; PG8_LDA(At, 1, 0); PG8_STAGE(PG8_SA(0, 1), a2 + hstep, voffA);
            PG8_WAIT_L(8); PG8_BAR; PG8_WAIT_L(0); PG8_MMA(0, 0, At, B0); PG8_BAR; PG8_SCHED;
            PG8_LDB(B1, 1, 1); PG8_STAGE(PG8_SB(1, 0), b3, voffB);
            PG8_BAR; PG8_WAIT_L(0); PG8_MMA(0, 1, At, B1); PG8_BAR;
            PG8_LDA(At, 1, 1); PG8_STAGE(PG8_SA(1, 0), a3, voffA);
            PG8_BAR; PG8_WAIT_L(0); PG8_MMA(1, 0, At, B0); PG8_BAR; PG8_SCHED;
            PG8_STAGE(PG8_SB(1, 1), b3 + hstepB, voffB);
            PG8_WAIT_V(6); PG8_BAR; PG8_MMA(1, 1, At, B1); PG8_BAR;
            }
        }
        if constexpr (ALIGN_EPI) { if (wr == 0) PG8_BAR; }
        E(acc, cur, wr, wc, fr, fq);
        if (!has_next) break;
#pragma unroll
        for (int a = 0; a < 2; ++a)
#pragma unroll
            for (int b = 0; b < 2; ++b)
#pragma unroll
                for (int m = 0; m < 4; ++m)
#pragma unroll
                    for (int n = 0; n < 2; ++n) acc[a][b][m][n] = (f32x4){0.f, 0.f, 0.f, 0.f};
        cur = nxt; cA = nA; cB = nB; ++ui;
        if constexpr (ALIGN_EPI) { if (wr == 1) PG8_BAR; }
    }
    PG8_WAIT_V(0);
    if constexpr (!ALIGN_EPI) { if (wr == 0) PG8_BAR; }
    PG8_BAR;
#undef PG8_SA
#undef PG8_SB
#undef PG8_STAGE
#undef PG8_LDA
#undef PG8_LDB
#undef PG8_MMA
#undef PG8_WAIT_V
#undef PG8_WAIT_L
#undef PG8_BAR
#undef PG8_SCHED
}
}

struct EpiIn {
    static constexpr int BHALF = 32;
    __host__ __device__ static int brow(int R) { return 64 * (R >> 5) + pg8::perm32(R & 31); }
    bf16_t* HM; float* GB; const float *q_gain_a, *k_gain_a, *q_gain_b, *k_gain_sel, *k_gain_win, *b_gate;
    DI void operator()(const f32x4 (&acc)[2][2][4][2], const pg8::Unit& u, int wr, int wc, int fr, int fq) const {
        const int row0 = u.pm * 256 + wr * 64 + fr;
        const int slot = u.pn * 4 + wc;
        bf16_t* base = HM + ((size_t)slot * M + row0) * 64 + 8 * fq;
        const float* gain = nullptr; float extra = 1.f; int kind = 0;
        if (slot < 8) { gain = q_gain_a; extra = 0.125f * LOG2E; kind = 1; }
        else if (slot < 10) { gain = k_gain_a; kind = 1; }
        else if (slot < 12) kind = 0;
        else if (slot < 20) kind = 2;
        else if (slot < 28) { gain = q_gain_b; extra = 0.125f * LOG2E; kind = 1; }
        else if (slot < 32) kind = 0;
        else if (slot < 34) { gain = k_gain_sel; kind = 1; }
        else if (slot < 36) kind = 0;
        else if (slot < 38) { gain = k_gain_win; kind = 1; }
        else if (slot < 40) kind = 0;
        else kind = 2;
        if (kind == 1) {
            f32x4 gv[2][2];
#pragma unroll
            for (int bj = 0; bj < 2; ++bj)
#pragma unroll
                for (int n = 0; n < 2; ++n) gv[bj][n] = *(const f32x4*)(gain + 32 * bj + 8 * fq + 4 * n);
#pragma unroll
            for (int ai = 0; ai < 2; ++ai)
#pragma unroll
                for (int m = 0; m < 4; ++m) {
                    float ss = 0.f;
#pragma unroll
                    for (int bj = 0; bj < 2; ++bj)
#pragma unroll
                        for (int n = 0; n < 2; ++n) { const f32x4 a = acc[ai][bj][m][n]; ss += (a.x * a.x + a.y * a.y) + (a.z * a.z + a.w * a.w); }
                    ss += __shfl_xor(ss, 16); ss += __shfl_xor(ss, 32);
                    const float rs = rsq(ss * (1.f / 64.f) + EPS) * extra;
#pragma unroll
                    for (int bj = 0; bj < 2; ++bj) { const f32x4 v0 = acc[ai][bj][m][0] * rs * gv[bj][0], v1 = acc[ai][bj][m][1] * rs * gv[bj][1];
                        u32x4 w; w.x = pk2(v0.x, v0.y); w.y = pk2(v0.z, v0.w); w.z = pk2(v1.x, v1.y); w.w = pk2(v1.z, v1.w);
                        *(u32x4*)(base + (size_t)(ai * 128 + m * 16) * 64 + 32 * bj) = w; }
                }
        } else {
#pragma unroll
            for (int ai = 0; ai < 2; ++ai)
#pragma unroll
                for (int m = 0; m < 4; ++m)
#pragma unroll
                    for (int bj = 0; bj < 2; ++bj) { f32x4 v0 = acc[ai][bj][m][0], v1 = acc[ai][bj][m][1];
                        if (kind == 2) { v0.x *= sigm(v0.x); v0.y *= sigm(v0.y); v0.z *= sigm(v0.z); v0.w *= sigm(v0.w);
                                         v1.x *= sigm(v1.x); v1.y *= sigm(v1.y); v1.z *= sigm(v1.z); v1.w *= sigm(v1.w); }
                        u32x4 w; w.x = pk2(v0.x, v0.y); w.y = pk2(v0.z, v0.w); w.z = pk2(v1.x, v1.y); w.w = pk2(v1.z, v1.w);
                        *(u32x4*)(base + (size_t)(ai * 128 + m * 16) * 64 + 32 * bj) = w; }
        }
    }
};
struct EpiOut {
    static constexpr int BHALF = 128;
    __host__ __device__ static int brow(int R) { return R; }
    const float* x; const float* mod; float* out;
    DI void operator()(const f32x4 (&acc)[2][2][4][2], const pg8::Unit& u, int wr, int wc, int fr, int fq) const {
        const int row0 = u.pm * 256 + wr * 64 + fr, col0 = u.pn * 256 + wc * 32 + 4 * fq;
        const float* gate = mod + (u.pm >> 4) * 3072 + 2048 + col0;
        f32x4 gv[2][2];
#pragma unroll
        for (int bj = 0; bj < 2; ++bj)
#pragma unroll
            for (int n = 0; n < 2; ++n) gv[bj][n] = *(const f32x4*)(gate + bj * 128 + n * 16);
        f32x4 xa[2][2][2], xb[2][2][2];
#define EO_OFF(q, mm) ((size_t)(row0 + ((q) >> 1) * 128 + (((q) & 1) * 2 + (mm)) * 16) * 1024 + col0)
#define EO_LOAD(XV, q) do { _Pragma("unroll") for (int mm = 0; mm < 2; ++mm) _Pragma("unroll") for (int bj = 0; bj < 2; ++bj) _Pragma("unroll") for (int n = 0; n < 2; ++n) \
            XV[mm][bj][n] = *(const f32x4*)(x + EO_OFF(q, mm) + bj * 128 + n * 16); } while (0)
#define EO_STORE(XV, q) do { _Pragma("unroll") for (int mm = 0; mm < 2; ++mm) _Pragma("unroll") for (int bj = 0; bj < 2; ++bj) _Pragma("unroll") for (int n = 0; n < 2; ++n) \
            *(f32x4*)(out + EO_OFF(q, mm) + bj * 128 + n * 16) = XV[mm][bj][n] + gv[bj][n] * acc[(q) >> 1][bj][((q) & 1) * 2 + mm][n]; } while (0)
        __builtin_amdgcn_s_waitcnt(0x0F70);
        EO_LOAD(xa, 0);
        __builtin_amdgcn_sched_barrier(0);
        EO_LOAD(xb, 1);
        __builtin_amdgcn_sched_barrier(0);
        EO_STORE(xa, 0);
        __builtin_amdgcn_sched_barrier(0);
        EO_LOAD(xa, 2);
        __builtin_amdgcn_sched_barrier(0);
        EO_STORE(xb, 1);
        __builtin_amdgcn_sched_barrier(0);
        EO_LOAD(xb, 3);
        __builtin_amdgcn_sched_barrier(0);
        EO_STORE(xa, 2);
        EO_STORE(xb, 3);
        asm volatile("" ::: "memory");
#undef EO_OFF
#undef EO_LOAD
#undef EO_STORE
    }
};

DI void p0_mod_a(const Params& p, char* lds, int ht) {
    float* sc = (float*)lds;
    for (int i = ht; i < 16384; i += 256) { const int b = i >> 10, k = i & 1023; const float cv = p.c[i]; sc[k * 16 + b] = cv * sigm(cv); }
}
DI void p0_mod_b(const Params& p, int item, char* lds, int ht) {
    const int col = ht & 15, kg = ht >> 4, n0 = item * 16;
    const float* sc = (const float*)lds; float* red = (float*)(lds + 65536);
    float acc[16];
#pragma unroll
    for (int b = 0; b < 16; ++b) acc[b] = 0.f;
#pragma unroll 1
    for (int c = 0; c < 4; ++c) {
        float wv[16];
#pragma unroll
        for (int kk = 0; kk < 16; ++kk) wv[kk] = p.w_ada[(size_t)(kg * 64 + c * 16 + kk) * 3072 + n0 + col];
#pragma unroll 4
        for (int kk = 0; kk < 16; ++kk) {
            const int k = kg * 64 + c * 16 + kk;
            const float w = wv[kk];
            const f32x4* s4 = (const f32x4*)(sc + k * 16);
#pragma unroll
            for (int q = 0; q < 4; ++q) { const f32x4 s = s4[q]; acc[4 * q] += s.x * w; acc[4 * q + 1] += s.y * w; acc[4 * q + 2] += s.z * w; acc[4 * q + 3] += s.w * w; }
        }
    }
#pragma unroll
    for (int b = 0; b < 16; ++b) { float a = acc[b]; a += __shfl_xor(a, 16); a += __shfl_xor(a, 32); if ((ht & 63) < 16) red[((ht >> 6) * 16 + b) * 16 + col] = a; }
}
DI void p0_mod_c(const Params& p, int item, char* lds, int ht, float* mod) {
    const int col = ht & 15, b = ht >> 4, n0 = item * 16; const float* red = (const float*)(lds + 65536);
    const float s = (red[(0 * 16 + b) * 16 + col] + red[(1 * 16 + b) * 16 + col]) + (red[(2 * 16 + b) * 16 + col] + red[(3 * 16 + b) * 16 + col]);
    mod[b * 3072 + n0 + col] = s + p.b_ada[n0 + col];
}
DI void p0_tr_a(const float* src, int N, int kb, int nb, char* lds, int ht) {
    float* t = (float*)lds; const int k0 = kb * 64, n0 = nb * 64;
#pragma unroll 4
    for (int i = 0; i < 16; ++i) { const int r = i * 4 + (ht >> 6), cc = ht & 63;
        t[r * 65 + cc] = (n0 + cc < N) ? src[(size_t)(k0 + r) * N + n0 + cc] : 0.f; }
}
DI void p0_tr_b(bf16_t* dst, int K, int kb, int nb, char* lds, int ht) {
    const float* t = (const float*)lds; const int k0 = kb * 64, n0 = nb * 64, n = ht >> 2, kc = (ht & 3) * 16;
    u32x4 o0, o1;
    o0.x = pk2(t[(kc + 0) * 65 + n], t[(kc + 1) * 65 + n]); o0.y = pk2(t[(kc + 2) * 65 + n], t[(kc + 3) * 65 + n]);
    o0.z = pk2(t[(kc + 4) * 65 + n], t[(kc + 5) * 65 + n]); o0.w = pk2(t[(kc + 6) * 65 + n], t[(kc + 7) * 65 + n]);
    o1.x = pk2(t[(kc + 8) * 65 + n], t[(kc + 9) * 65 + n]); o1.y = pk2(t[(kc + 10) * 65 + n], t[(kc + 11) * 65 + n]);
    o1.z = pk2(t[(kc + 12) * 65 + n], t[(kc + 13) * 65 + n]); o1.w = pk2(t[(kc + 14) * 65 + n], t[(kc + 15) * 65 + n]);
    u32x4* d = (u32x4*)(dst + (size_t)(n0 + n) * K + k0 + kc); d[0] = o0; d[1] = o1;
}
DI void p0_b1_a(const Params& p, int item, char* lds, int ht) {
    const int kv = item >> 2, n0 = (item & 3) * 64, col = ht & 63, kg = ht >> 6;
    const float* pos = kv ? p.cmp_pos_v : p.cmp_pos_k; const float* w1 = kv ? p.w_cmp_v1 : p.w_cmp_k1;
    float a = 0.f;
#pragma unroll 8
    for (int kk = 0; kk < 512; ++kk) { const int k = kg * 512 + kk; a += pos[k] * w1[(size_t)k * 256 + n0 + col]; }
    ((float*)lds)[kg * 64 + col] = a;
}
DI void p0_b1_b(int item, char* lds, int ht, float* bias1) {
    const float* red = (const float*)lds; const int kv = item >> 2, n0 = (item & 3) * 64;
    if (ht < 64) bias1[kv * 256 + n0 + ht] = (red[ht] + red[64 + ht]) + (red[128 + ht] + red[192 + ht]);
}
DI void p0_tbl(const Params& p, int kind, int ht, float* T) {
    const float* gq = kind == 0 ? p.q_gain_a : p.q_gain_b; const float* gk = kind == 0 ? p.k_gain_a : (kind == 1 ? p.k_gain_sel : p.k_gain_win);
    const int head0 = kind == 0 ? 0 : 8;
    float gm = 0.f;
    for (int d = 0; d < 64; ++d) gm = fmaxf(gm, fabsf(gq[d] * gk[d]));
    for (int idx = ht; idx < 8 * 464; idx += 256) { const int r = idx / 464, rem = idx - r * 464, cp = rem / 232, i = rem - cp * 232;
        int dist = 191 - i - cp; dist = dist < 0 ? 0 : (dist > 128 ? 128 : dist);
        float bm = 0.f;
        for (int bk = 0; bk < 32; ++bk) bm = fmaxf(bm, p.rel_bias[bk * 16 + head0 + r]);
        const float shift = 8.f * gm + bm;
        T[(kind * 8 + r) * 464 + rem] = (p.rel_bias[t5_bucket(dist) * 16 + head0 + r] - shift) * LOG2E;
        if (rem == 0) T[3 * 8 * 464 + kind * 8 + r] = shift; }
    if (ht == 0) T[3 * 8 * 464 + 25 + kind] = -8.f * gm * LOG2E;
    if (kind == 0 && ht == 0) { float gc = 0.f; for (int d = 0; d < 64; ++d) gc = fmaxf(gc, fabsf(p.q_gain_b[d] * p.k_gain_cmp[d])); T[3 * 8 * 464 + 24] = -8.f * gc * LOG2E; }
}
DI void phase0(const Params& p, char* lds0) {
    float* mod = (float*)(p.ws + WS_MOD); float* bias1 = (float*)(p.ws + WS_BIAS1);
    bf16_t* WinT = (bf16_t*)(p.ws + WS_WINT); bf16_t* WoutT = (bf16_t*)(p.ws + WS_WOUTT);
    bf16_t* W1T = (bf16_t*)(p.ws + WS_W1T); bf16_t* W2T = (bf16_t*)(p.ws + WS_W2T);
    constexpr int I_MOD = 192, I_TBL = 3, I_B1 = 8, I_WIN = 16 * 48, I_WOUT = 16 * 16, I_W1 = 32 * 4, I_W2 = 4;
    constexpr int NITEMS = I_MOD + I_TBL + I_B1 + I_WIN + I_WOUT + 2 * I_W1 + 2 * I_W2;
    const int half = threadIdx.x >> 8, ht = threadIdx.x & 255;
    char* lds = lds0 + half * 73728;
    for (int it = blockIdx.x; 2 * it < NITEMS; it += gridDim.x) {
        const int item = 2 * it + half; const bool valid = item < NITEMS;
        int r = item, type = -1, a = 0;
        const float* src = nullptr; bf16_t* dst = nullptr; int K = 0, N = 0, kb = 0, nb = 0;
        if (valid) {
            if (r < I_MOD) { type = 0; a = r; }
            else if ((r -= I_MOD) < I_TBL) { type = 3; a = r; }
            else if ((r -= I_TBL) < I_B1) { type = 1; a = r; }
            else if ((r -= I_B1) < I_WIN) { type = 2; src = p.w_in; dst = WinT; K = 1024; N = NPROJ; kb = r / 48; nb = r % 48; }
            else if ((r -= I_WIN) < I_WOUT) { type = 2; src = p.w_out; dst = WoutT; K = 1024; N = 1024; kb = r / 16; nb = r % 16; }
            else if ((r -= I_WOUT) < I_W1) { type = 2; src = p.w_cmp_k1; dst = W1T; K = 2048; N = 256; kb = r / 4; nb = r % 4; }
            else if ((r -= I_W1) < I_W1) { type = 2; src = p.w_cmp_v1; dst = W1T + 256 * 2048; K = 2048; N = 256; kb = r / 4; nb = r % 4; }
            else if ((r -= I_W1) < I_W2) { type = 2; src = p.w_cmp_k2; dst = W2T; K = 256; N = 64; kb = r; nb = 0; }
            else { r -= I_W2; type = 2; src = p.w_cmp_v2; dst = W2T + 64 * 256; K = 256; N = 64; kb = r; nb = 0; }
        }
        if (type == 0) p0_mod_a(p, lds, ht); else if (type == 3) p0_tbl(p, a, ht, (float*)(p.ws + WS_TBL));
        __syncthreads();
        if (type == 0) p0_mod_b(p, a, lds, ht); else if (type == 1) p0_b1_a(p, a, lds, ht); else if (type == 2) p0_tr_a(src, N, kb, nb, lds, ht);
        __syncthreads();
        if (type == 0) p0_mod_c(p, a, lds, ht, mod); else if (type == 1) p0_b1_b(a, lds, ht, bias1); else if (type == 2) p0_tr_b(dst, K, kb, nb, lds, ht);
        __syncthreads();
    }
}

constexpr int L1_AB = 0, L1_WG = 8192, L1_WGS = 2064  , L1_WGROWS = 25  , L1_SS = L1_WG + L1_WGROWS * L1_WGS,
              L1_ACCS = 36  , L1_ACCB = 2 * 128 * L1_ACCS * 4, L1_ACC = L1_SS + 2 * 1024, L1_VB = L1_ACC + 2 * L1_ACCB, L1_END = L1_VB + 128;
static_assert(L1_END <= 147456 && L1_SS % 16 == 0 && L1_ACC % 16 == 0, "P1 LDS map");
DI void phase1(const Params& p, char* lds) {
    bf16_t* H = (bf16_t*)(p.ws + WS_H); float* GB = (float*)(p.ws + WS_GB); const float* mod = (const float*)(p.ws + WS_MOD);
    float* AB = (float*)(lds + L1_AB); float* VB = (float*)(lds + L1_VB);
    for (int rt = blockIdx.x; rt < M / 256; rt += gridDim.x) {
        int tid_ = threadIdx.x; asm volatile("" : "+v"(tid_));
        const int tid = tid_, lane = tid & 63, w = tid >> 6, tok = lane & 15, kq = lane >> 4;
        const int b = rt >> 4;
        const float* shift = mod + b * 3072; const float* scale = shift + 1024;
        __syncthreads();
        for (int k = tid; k < 1024; k += NTHREADS) { AB[k] = p.norm_gain[k] * (1.f + scale[k]); AB[1024 + k] = shift[k]; }
        __syncthreads();
        { const int c = tid & 31, kc = tid >> 5; float av = 0.f;
#pragma unroll 8
          for (int it = 0; it < 64; ++it) { const int k = kc + 16 * it; const float wr = c < 24 ? p.w_in[(size_t)k * NPROJ + 3072 + c] : 0.f;
              av += AB[1024 + k] * wr;
              if (c < L1_WGROWS) *(bf16_t*)(lds + L1_WG + c * L1_WGS + k * 2) = (bf16_t)(pk2(wr * AB[k], 0.f) & 0xffffu); }
          ((float*)(lds + L1_ACC))[kc * 32 + c] = av; }
        __syncthreads();
        if (tid < 32) { float a = 0.f; for (int kc = 0; kc < 16; ++kc) a += ((const float*)(lds + L1_ACC))[kc * 32 + tid]; VB[tid] = a + (tid < 24 ? p.b_gate[tid] : 0.f); }
        __syncthreads();
        const float* xb = p.x + ((size_t)rt * 256 + tok) * 1024 + 128 * w + 8 * kq;
        const char* wgA = lds + L1_WG + tok * L1_WGS + (128 * w + 8 * kq) * 2;
        const char* wgB = lds + L1_WG + (tok < 8 ? 16 + tok : 24) * L1_WGS + (128 * w + 8 * kq) * 2;
        f32x4 xsa[2][4][2], xsb[2][4][2];
#pragma unroll
        for (int r = 0; r < 2; ++r)
#pragma unroll
            for (int s = 0; s < 4; ++s) { xsa[r][s][0] = *(const f32x4*)(xb + r * 16 * 1024 + 32 * s); xsa[r][s][1] = *(const f32x4*)(xb + r * 16 * 1024 + 32 * s + 4); }
        auto step = [&](f32x4 (&xv)[2][4][2], f32x4 (&xl)[2][4][2], const int g) {
            if (g + 1 < 8) { const float* xg = xb + (size_t)(g + 1) * 32 * 1024;
#pragma unroll
                for (int r = 0; r < 2; ++r)
#pragma unroll
                    for (int s = 0; s < 4; ++s) { xl[r][s][0] = *(const f32x4*)(xg + r * 16 * 1024 + 32 * s); xl[r][s][1] = *(const f32x4*)(xg + r * 16 * 1024 + 32 * s + 4); } }
            float* SS = (float*)(lds + L1_SS + (g & 1) * 1024); float* ACC = (float*)(lds + L1_ACC + (g & 1) * L1_ACCB);
            float ss[2] = {0.f, 0.f}; f32x4 a0[2], a1[2];
#pragma unroll
            for (int r = 0; r < 2; ++r) { a0[r] = (f32x4){0.f, 0.f, 0.f, 0.f}; a1[r] = (f32x4){0.f, 0.f, 0.f, 0.f}; }
#pragma unroll
            for (int s = 0; s < 4; ++s) {
                const bf16x8 wf0 = *(const bf16x8*)(wgA + 64 * s), wf1 = *(const bf16x8*)(wgB + 64 * s);
#pragma unroll
                for (int r = 0; r < 2; ++r) {
                    const f32x4 u = xv[r][s][0], v = xv[r][s][1];
                    ss[r] += (u.x * u.x + u.y * u.y) + (u.z * u.z + u.w * u.w) + (v.x * v.x + v.y * v.y) + (v.z * v.z + v.w * v.w);
                    u32x4 pb; pb.x = pk2(u.x, u.y); pb.y = pk2(u.z, u.w); pb.z = pk2(v.x, v.y); pb.w = pk2(v.z, v.w);
                    const bf16x8 xf = __builtin_bit_cast(bf16x8, pb);
                    a0[r] = mfma16(wf0, xf, a0[r]); a1[r] = mfma16(wf1, xf, a1[r]);
                }
            }
#pragma unroll
            for (int r = 0; r < 2; ++r) {
                float t = ss[r]; t += __shfl_xor(t, 16); t += __shfl_xor(t, 32);
                if (kq == 0) SS[r * 128 + w * 16 + tok] = t;
                float* ar = ACC + (r * 128 + w * 16 + tok) * L1_ACCS + 4 * kq;
                *(f32x4*)ar = a0[r]; *(f32x4*)(ar + 16) = a1[r];
            }
            __syncthreads();
            float rstd[2];
#pragma unroll
            for (int r = 0; r < 2; ++r) { float t = 0.f;
#pragma unroll
                for (int ww = 0; ww < 8; ++ww) t += SS[r * 128 + ww * 16 + tok];
                rstd[r] = rsq(t * (1.f / 1024.f) + EPS); }
            bf16_t* hrow = H + ((size_t)rt * 256 + g * 32 + tok) * 1024 + 128 * w + 8 * kq;
#pragma unroll
            for (int s = 0; s < 4; ++s) { const int k = 128 * w + 32 * s + 8 * kq;
                const f32x4 g0 = *(const f32x4*)(AB + k), g1 = *(const f32x4*)(AB + k + 4), s0 = *(const f32x4*)(AB + 1024 + k), s1 = *(const f32x4*)(AB + 1024 + k + 4);
#pragma unroll
                for (int r = 0; r < 2; ++r) {
                    const f32x4 h0 = xv[r][s][0] * rstd[r] * g0 + s0, h1 = xv[r][s][1] * rstd[r] * g1 + s1;
                    u32x4 o; o.x = pk2(h0.x, h0.y); o.y = pk2(h0.z, h0.w); o.z = pk2(h1.x, h1.y); o.w = pk2(h1.z, h1.w);
                    *(u32x4*)(hrow + r * 16 * 1024 + 32 * s) = o; } }
            { const int t32 = tid >> 4, cp = tid & 15;
              const float* SSr = SS + (t32 >> 4) * 128 + (t32 & 15); const float* ACr = ACC + ((t32 >> 4) * 128 + (t32 & 15)) * L1_ACCS + cp;
              float t = 0.f, v0 = 0.f, v1 = 0.f;
#pragma unroll
              for (int ww = 0; ww < 8; ++ww) { t += SSr[ww * 16]; v0 += ACr[ww * 16 * L1_ACCS]; v1 += ACr[ww * 16 * L1_ACCS + 16]; }
              const float rs = rsq(t * (1.f / 1024.f) + EPS);
              float* gp = GB + ((size_t)rt * 256 + g * 32 + t32) * 24 + cp;
              gp[0] = sigm(rs * v0 + VB[cp]);
              if (cp < 8) gp[16] = sigm(rs * v1 + VB[16 + cp]); }
        };
#pragma unroll 1
        for (int g = 0; g < 8; g += 2) { step(xsa, xsb, g); step(xsb, xsa, g + 1); }
    }
}

DI void p3_item(const Params& p, int item, char* lds, int tid) {
    const int lane = tid & 63, w = tid >> 6;
    const int kv = item & 1, ct = (item >> 1) & 7, bg = item >> 4, b = bg >> 1, g = bg & 1;
    const bf16_t* HM = (const bf16_t*)(p.ws + WS_HM);
    const int slot = (kv ? 30 : 28) + g;
    const bf16_t* Xbase = HM + ((size_t)slot * M + (size_t)b * 4096) * 64;
    const bf16_t* W1 = (const bf16_t*)(p.ws + WS_W1T) + (size_t)kv * 256 * 2048;
    const bf16_t* W2 = (const bf16_t*)(p.ws + WS_W2T) + (size_t)kv * 64 * 256;
    const float* bias1 = (const float*)(p.ws + WS_BIAS1) + kv * 256;
    const int srow = tid >> 3, sch = tid & 7;
    const int sofs = srow * 128 + ((sch ^ ((srow >> 1) & 7)) << 4);
    int cx = ct * 32 + srow; if (cx > 254) cx = 254;
    const bf16_t* xp = Xbase + (size_t)cx * 1024 + sch * 8;
    const bf16_t* wp = W1 + (size_t)srow * 2048 + sch * 8;
    constexpr int STG = 36864;
    u32x4 wrA[8], wrB[8], xrA, xrB;
    f32x4 acc[4][2];
#pragma unroll
    for (int i = 0; i < 4; ++i) { acc[i][0] = (f32x4){0.f, 0.f, 0.f, 0.f}; acc[i][1] = (f32x4){0.f, 0.f, 0.f, 0.f}; }
#define P3_LOAD(WR, XR, KT) do { _Pragma("unroll") for (int q = 0; q < 8; ++q) WR[q] = *(const u32x4*)(wp + (size_t)q * 32 * 2048 + (KT) * 64); XR = *(const u32x4*)(xp + (KT) * 64); } while (0)
#define P3_STORE(WR, XR, BUF) do { char* d_ = lds + (BUF) * STG; _Pragma("unroll") for (int q = 0; q < 8; ++q) *(u32x4*)(d_ + sofs + q * 4096) = WR[q]; *(u32x4*)(d_ + 32768 + sofs) = XR; } while (0)
#define P3_COMPUTE(BUF) do { const char* sW = lds + (BUF) * STG; const char* sX = sW + 32768; \
        _Pragma("unroll") for (int ks = 0; ks < 2; ++ks) { const int co = ((ks * 4 + fq) ^ fsw) << 4; bf16x8 wf[4], xf[2]; \
            _Pragma("unroll") for (int i = 0; i < 4; ++i) wf[i] = *(const bf16x8*)(sW + (w * 64 + i * 16) * 128 + fro + co); \
            _Pragma("unroll") for (int i = 0; i < 2; ++i) xf[i] = *(const bf16x8*)(sX + (i * 16) * 128 + fro + co); \
            _Pragma("unroll") for (int ni = 0; ni < 4; ++ni) _Pragma("unroll") for (int mi = 0; mi < 2; ++mi) acc[ni][mi] = mfma16(wf[ni], xf[mi], acc[ni][mi]); } } while (0)
    const int fro = (lane & 15) * 128, fsw = (lane >> 1) & 7, fq = lane >> 4;
    P3_LOAD(wrA, xrA, 0); P3_LOAD(wrB, xrB, 1);
    P3_STORE(wrA, xrA, 0);
    __syncthreads();
    for (int kt = 0; kt < 32; kt += 2) {
        if (kt + 2 < 32) P3_LOAD(wrA, xrA, kt + 2);
        P3_COMPUTE(0);
        P3_STORE(wrB, xrB, 1);
        __syncthreads();
        if (kt + 3 < 32) P3_LOAD(wrB, xrB, kt + 3);
        P3_COMPUTE(1);
        if (kt + 2 < 32) P3_STORE(wrA, xrA, 0);
        __syncthreads();
    }
#undef P3_LOAD
#undef P3_STORE
#undef P3_COMPUTE
    char* Hs = lds;
    float* Os = (float*)(lds + 16384);
    {
        const int dq = (lane >> 4) * 4;
#pragma unroll
        for (int ni = 0; ni < 4; ++ni) { const int n = w * 64 + ni * 16 + dq; const f32x4 bv = *(const f32x4*)(bias1 + n);
#pragma unroll
            for (int mi = 0; mi < 2; ++mi) { const int m = mi * 16 + (lane & 15); const f32x4 a = acc[ni][mi] + bv;
                u32x2 o; o.x = pk2(a.x * sigm(a.x), a.y * sigm(a.y)); o.y = pk2(a.z * sigm(a.z), a.w * sigm(a.w));
                *(u32x2*)(Hs + m * 512 + (((n >> 3) ^ (m & 15)) << 4) + ((n >> 2) & 1) * 8) = o; } }
    }
    __syncthreads();
    {
        f32x4 a2[2] = {(f32x4){0.f, 0.f, 0.f, 0.f}, (f32x4){0.f, 0.f, 0.f, 0.f}};
        const bf16_t* w2p = W2 + (size_t)(w * 16 + (lane & 15)) * 256 + fq * 8;
#pragma unroll
        for (int ks = 0; ks < 8; ++ks) {
            const bf16x8 wf = *(const bf16x8*)(w2p + ks * 32);
#pragma unroll
            for (int mi = 0; mi < 2; ++mi) { const int m = mi * 16 + (lane & 15);
                const bf16x8 xf = *(const bf16x8*)(Hs + m * 512 + (((ks * 4 + fq) ^ (m & 15)) << 4));
                a2[mi] = mfma16(wf, xf, a2[mi]); }
        }
#pragma unroll
        for (int mi = 0; mi < 2; ++mi) *(f32x4*)(Os + (mi * 16 + (lane & 15)) * 68 + w * 16 + fq * 4) = a2[mi];
    }
    __syncthreads();
    {
        const int m = tid >> 3, d0 = (tid & 7) * 8;
        f32x4 v0 = *(const f32x4*)(Os + m * 68 + d0), v1 = *(const f32x4*)(Os + m * 68 + d0 + 4);
        if (kv == 0) {
            float ss = (v0.x * v0.x + v0.y * v0.y) + (v0.z * v0.z + v0.w * v0.w) + (v1.x * v1.x + v1.y * v1.y) + (v1.z * v1.z + v1.w * v1.w);
            ss += __shfl_xor(ss, 1); ss += __shfl_xor(ss, 2); ss += __shfl_xor(ss, 4);
            const float rs = rsq(ss * (1.f / 64.f) + EPS);
            v0 = v0 * rs * *(const f32x4*)(p.k_gain_cmp + d0); v1 = v1 * rs * *(const f32x4*)(p.k_gain_cmp + d0 + 4);
        }
        u32x4 o; o.x = pk2(v0.x, v0.y); o.y = pk2(v0.z, v0.w); o.z = pk2(v1.x, v1.y); o.w = pk2(v1.z, v1.w);
        *(u32x4*)((bf16_t*)(p.ws + (kv ? WS_VCMP : WS_KCMP)) + ((size_t)bg * 256 + ct * 32 + m) * 64 + d0) = o;
    }
    __syncthreads();
}
DI void phase3(const Params& p, char* lds) {
    const int half = threadIdx.x >> 8, ht = threadIdx.x & 255;
    for (int it = blockIdx.x; it < 256; it += gridDim.x) p3_item(p, 2 * it + half, lds + half * 73728, ht);
}

constexpr int L4_WSCR = 65536;
constexpr int L4_TBL0 = L4_WSCR + 8 * 8448;
constexpr int L4_TBL1 = L4_TBL0 + 7424;
constexpr int L4_SC = L4_TBL1 + 7424;
constexpr int L4_UNIT = L4_SC + 64;
static_assert(L4_UNIT + 16 <= LDS_MISC, "P4 LDS map");
struct WB { int hi_min, hi_max, lo_min, lo_max; };

template <int OFF> DI s16x4 tr_read(unsigned a) { s16x4 r; asm volatile("ds_read_b64_tr_b16 %0, %1 offset:%2" : "=&v"(r) : "v"(a), "i"(OFF) : "memory"); return r; }
#define TR_WAIT() do { asm volatile("s_waitcnt lgkmcnt(0)" ::: "memory"); __builtin_amdgcn_sched_barrier(0); } while (0)
#define PK8(L, H) (bf16x8){L[0], L[1], L[2], L[3], H[0], H[1], H[2], H[3]}
struct LaneC { int kA, vA0, vA1, Xc, h4; };
DI void pack_p(const f32x16& s, float& lsum, bf16x8 (&pf)[2]) {
    float e[16];
#pragma unroll
    for (int r = 0; r < 16; ++r) e[r] = ex2(s[r]);
    float t0 = (e[0] + e[1]) + (e[2] + e[3]), t1 = (e[4] + e[5]) + (e[6] + e[7]), t2 = (e[8] + e[9]) + (e[10] + e[11]), t3 = (e[12] + e[13]) + (e[14] + e[15]);
    lsum += (t0 + t1) + (t2 + t3);
#pragma unroll
    for (int s2 = 0; s2 < 2; ++s2) { u32x4 pp; pp.x = pk2(e[8 * s2 + 0], e[8 * s2 + 1]); pp.y = pk2(e[8 * s2 + 2], e[8 * s2 + 3]);
        pp.z = pk2(e[8 * s2 + 4], e[8 * s2 + 5]); pp.w = pk2(e[8 * s2 + 6], e[8 * s2 + 7]); pf[s2] = __builtin_bit_cast(bf16x8, pp); }
}
DI void subtile2_pv(const char* lds, int stoff  , int k0, const LaneC& lc, const bf16x8 (&qa)[4], const bf16x8 (&qb)[4],
                    f32x16 (&OA)[2], f32x16 (&OB)[2], float& lA, float& lB,
                    const f32x16& cin  , float tadd  , bool use_tbl, int tboffA, int tboffB,
                    bool need_hi, int hi_t, bool need_lo, int lo_t) {
    f32x16 sa, sb;
    bf16x8 kf[4];
#pragma unroll
    for (int ks = 0; ks < 4; ++ks) kf[ks] = *(const bf16x8*)(lds + stoff + (lc.kA ^ (ks << 5)));
    sa = cin; sb = cin;
    __builtin_amdgcn_s_setprio(1);
#pragma unroll
    for (int ks = 0; ks < 4; ++ks) sa = mfma32(kf[ks], qa[ks], sa);
#pragma unroll
    for (int ks = 0; ks < 4; ++ks) sb = mfma32(kf[ks], qb[ks], sb);
    __builtin_amdgcn_s_setprio(0);
    if (use_tbl) {
        const int X = lc.Xc + k0; const int to = (X & 1) * 928 + (X & ~1) * 4; const char* tpa = lds + tboffA + to; const char* tpb = lds + tboffB + to;
#pragma unroll
        for (int q = 0; q < 4; ++q) { const f32x2 t0 = *(const f32x2*)(tpa + 32 * q), t1 = *(const f32x2*)(tpa + 32 * q + 8);
            sa[4 * q] += t0.x + tadd; sa[4 * q + 1] += t0.y + tadd; sa[4 * q + 2] += t1.x + tadd; sa[4 * q + 3] += t1.y + tadd;
            const f32x2 u0 = *(const f32x2*)(tpb + 32 * q), u1 = *(const f32x2*)(tpb + 32 * q + 8);
            sb[4 * q] += u0.x + tadd; sb[4 * q + 1] += u0.y + tadd; sb[4 * q + 2] += u1.x + tadd; sb[4 * q + 3] += u1.y + tadd; }
    }
    if (need_hi) { const int H = hi_t - k0 - lc.h4;
#pragma unroll
        for (int r = 0; r < 16; ++r) { const bool ok = (r & 3) + 8 * (r >> 2) <= H; sa[r] = ok ? sa[r] : -INFINITY; sb[r] = ok ? sb[r] : -INFINITY; } }
    if (need_lo) { const int L = lo_t - k0 - lc.h4;
#pragma unroll
        for (int r = 0; r < 16; ++r) { const bool ok = (r & 3) + 8 * (r >> 2) >= L; sa[r] = ok ? sa[r] : -INFINITY; sb[r] = ok ? sb[r] : -INFINITY; } }
    const unsigned vb = (unsigned)(size_t)(LAS const char*)lds + (unsigned)(stoff + 8192);
    const unsigned va0 = vb + (unsigned)lc.vA0, va1 = vb + (unsigned)lc.vA1;
    const s16x4 a0 = tr_read<0>(va0), a1 = tr_read<1024>(va0), a2 = tr_read<2048>(va0), a3 = tr_read<3072>(va0);
    const s16x4 b0 = tr_read<0>(va1), b1 = tr_read<1024>(va1), b2 = tr_read<2048>(va1), b3 = tr_read<3072>(va1);
    bf16x8 pa[2], pb[2];
    pack_p(sa, lA, pa);
    TR_WAIT();
    __builtin_amdgcn_s_setprio(1);
    OA[0] = mfma32(PK8(a0, a1), pa[0], OA[0]); OA[1] = mfma32(PK8(b0, b1), pa[0], OA[1]);
    OA[0] = mfma32(PK8(a2, a3), pa[1], OA[0]); OA[1] = mfma32(PK8(b2, b3), pa[1], OA[1]);
    __builtin_amdgcn_s_setprio(0);
    __builtin_amdgcn_sched_barrier(0);
    pack_p(sb, lB, pb);
    __builtin_amdgcn_sched_barrier(0);
    __builtin_amdgcn_s_setprio(1);
    OB[0] = mfma32(PK8(a0, a1), pb[0], OB[0]); OB[1] = mfma32(PK8(b0, b1), pb[0], OB[1]);
    OB[0] = mfma32(PK8(a2, a3), pb[1], OB[0]); OB[1] = mfma32(PK8(b2, b3), pb[1], OB[1]);
    __builtin_amdgcn_s_setprio(0);
}

DI void load_q(const bf16_t* HM, int slot, int m, int lane, bf16x8 (&qf)[4]) {
    const bf16_t* q = HM + ((size_t)slot * M + m) * 64 + (lane >> 5) * 8;
#pragma unroll
    for (int ks = 0; ks < 4; ++ks) qf[ks] = *(const bf16x8*)(q + ks * 16);
}
DI void write_y2(bf16_t* Y, const bf16_t* HM, int zslotA, int zslotB, int m, int colA, int colB, int lane, const f32x16 (&ya)[2], const f32x16 (&yb)[2]) {
    const int h = lane >> 5;
    const bf16_t* za = HM + ((size_t)zslotA * M + m) * 64 + 4 * h; const bf16_t* zb = HM + ((size_t)zslotB * M + m) * 64 + 4 * h;
    u32x2 zza[8], zzb[8];
#pragma unroll
    for (int i = 0; i < 8; ++i) { zza[i] = *(const u32x2*)(za + 8 * i); zzb[i] = *(const u32x2*)(zb + 8 * i); }
    asm volatile("" ::: "memory");
    bf16_t* ypa = Y + (size_t)m * 1024 + colA + 4 * h; bf16_t* ypb = Y + (size_t)m * 1024 + colB + 4 * h;
#pragma unroll
    for (int i = 0; i < 8; ++i) { const int db = i >> 2, rg = i & 3;
        u32x2 o; o.x = pk2(ya[db][4 * rg + 0] * bflo(zza[i].x), ya[db][4 * rg + 1] * bfhi(zza[i].x));
        o.y = pk2(ya[db][4 * rg + 2] * bflo(zza[i].y), ya[db][4 * rg + 3] * bfhi(zza[i].y));
        *(u32x2*)(ypa + 8 * i) = o;
        u32x2 q; q.x = pk2(yb[db][4 * rg + 0] * bflo(zzb[i].x), yb[db][4 * rg + 1] * bfhi(zzb[i].x));
        q.y = pk2(yb[db][4 * rg + 2] * bflo(zzb[i].y), yb[db][4 * rg + 3] * bfhi(zzb[i].y));
        *(u32x2*)(ypb + 8 * i) = q; }
}
DI float table_far(const float* tbl, int r) { return tbl[r * 464 + 63]; }
DI f32x16 cmp_qk(const char* lds, int st, int lane, const bf16x8 (&qf)[4]) {
    f32x16 s;
#pragma unroll
    for (int i = 0; i < 16; ++i) s[i] = 0.f;
    const int row = st * 32 + (lane & 31), h = lane >> 5; const char* kp = lds + row * 128; const int sw = (row >> 1) & 7;
#pragma unroll
    for (int ks = 0; ks < 4; ++ks) { const bf16x8 kf = *(const bf16x8*)(kp + (((2 * ks + h) ^ sw) << 4)); s = mfma32(kf, qf[ks], s); }
    return s;
}

DI void unit(const Params& p, bool isB, int bg, int qb, char* lds) {
    int tid_ = threadIdx.x; asm volatile("" : "+v"(tid_));
    const int tid = tid_, lane = tid & 63, w = __builtin_amdgcn_readfirstlane(tid >> 6), b = bg >> 1, g = bg & 1, h = lane >> 5;
    const bf16_t* HM = (const bf16_t*)(p.ws + WS_HM); bf16_t* Y = (bf16_t*)(p.ws + WS_Y); const float* GB = (const float*)(p.ws + WS_GB);
    float* tbl0 = (float*)(lds + L4_TBL0); float* tbl1 = (float*)(lds + L4_TBL1); float* sc = (float*)(lds + L4_SC);
    float* wsc = (float*)(lds + L4_WSCR + w * 8448) + lane;
    const int t0 = isB ? qb * 256 : qb * 128, tq0 = t0 + 32 * (isB ? w : (w & 3)), tq = tq0 + (lane & 31), m = b * 4096 + tq;
    const int thi = (t0 + (isB ? 255 : 127)) >> 6;
    const bf16_t* Kc = (const bf16_t*)(p.ws + WS_KCMP) + (size_t)bg * 256 * 64;
    const bf16_t* Vc = (const bf16_t*)(p.ws + WS_VCMP) + (size_t)bg * 256 * 64;
    const int hic_t = (tq - 31) >> 4;
    const int ctmax = ((t0 + 224) >> 4) >> 6;
    const float* TG = (const float*)(p.ws + WS_TBL);
    const float ccmp = TG[3 * 8 * 464 + 24];
    unsigned mask_even = 0xffffffffu, mask_odd = 0xffffffffu;
    {
        const int k0_ = isB ? 1 : 0;
        if (tid < 464) { *(f32x4*)(tbl0 + 4 * tid) = *(const f32x4*)(TG + (k0_ * 8 + 4 * g) * 464 + 4 * tid);
            if (isB) *(f32x4*)(tbl1 + 4 * tid) = *(const f32x4*)(TG + (2 * 8 + 4 * g) * 464 + 4 * tid); }
        if (tid < 4) sc[tid] = TG[3 * 8 * 464 + k0_ * 8 + 4 * g + tid];
    }
    if (isB) {
        const int nst = ((tq0 >> 4) >> 5) + 1;
        for (int i = tid; i < (ctmax + 1) * 512; i += NTHREADS) { const int row = i >> 3, ch = i & 7;
            *(u32x4*)(lds + row * 128 + ((ch ^ ((row >> 1) & 7)) << 4)) = *(const u32x4*)(Kc + (size_t)i * 8); }
        for (int i = 0; i < 33; ++i) wsc[i * 64] = 0.f;
        __syncthreads();
        {
            const int hic_min = (tq0 - 31) >> 4;
            f32x16 cinc;
#pragma unroll
            for (int i = 0; i < 16; ++i) cinc[i] = ccmp;
#pragma unroll 1
            for (int r = 0; r < 4; ++r) {
                bf16x8 qf[4]; load_q(HM, 20 + 4 * g + r, m, lane, qf);
                float lsum = 0.f;
                float E[33];
#pragma unroll
                for (int i = 0; i < 33; ++i) E[i] = 0.f;
#pragma unroll
                for (int st = 0; st < 8; ++st) {
                    if (st < nst) {
                        f32x16 s = cinc;
                        { const int row = st * 32 + (lane & 31); const char* kp = lds + row * 128; const int sw = (row >> 1) & 7;
#pragma unroll
                          for (int ks = 0; ks < 4; ++ks) { const bf16x8 kf = *(const bf16x8*)(kp + (((2 * ks + h) ^ sw) << 4)); s = mfma32(kf, qf[ks], s); } }
                        if (st * 32 + 31 > hic_min) { const int H = hic_t - st * 32 - 4 * h;
#pragma unroll
                            for (int i = 0; i < 16; ++i) s[i] = ((i & 3) + 8 * (i >> 2) <= H) ? s[i] : -INFINITY; }
#pragma unroll
                        for (int q = 0; q < 4; ++q) {
                            const float e0 = ex2(s[4 * q]), e1 = ex2(s[4 * q + 1]), e2 = ex2(s[4 * q + 2]), e3 = ex2(s[4 * q + 3]);
                            lsum += (e0 + e1) + (e2 + e3);
                            const float half = 0.5f * e3;
                            const float recv = __shfl_xor(half, 32);
                            E[st * 4 + q] += (e0 + e1) + (e2 + half) + (h ? recv : 0.f);
                            E[st * 4 + q + 1] += (h ? 0.f : recv);
                        }
                    }
                }
                const float l = lsum + __shfl_xor(lsum, 32);
                const float inv = l > 0.f ? 1.f / l : 0.f;
#pragma unroll
                for (int i = 0; i < 33; ++i) wsc[i * 64] += E[i] * inv;
            }
        }
        const int cur = tq0 >> 6;
        if (cur >= 16) {
            unsigned* keyL = (unsigned*)wsc;
#pragma unroll 4
            for (int i = 0; i < 32; ++i) { const int j = 2 * i + h; const bool ok = (j >= 1) && (j <= cur - 2);
                const unsigned bits = __builtin_bit_cast(unsigned, wsc[i * 64]);
                keyL[i * 64] = ok ? ((bits & 0xffffffc0u) + 64u + (unsigned)(63 - j)) : 0u; }
            mask_even = 1u; mask_odd = 0u;
            if (cur & 1) { mask_odd |= 1u << (cur >> 1); mask_even |= 1u << ((cur - 1) >> 1); }
            else { mask_even |= 1u << (cur >> 1); mask_odd |= 1u << ((cur - 1) >> 1); }
#pragma unroll 1
            for (int it = 0; it < 13; ++it) {
                unsigned mx = 0u;
#pragma unroll 8
                for (int i = 0; i < 32; ++i) { const unsigned k = keyL[i * 64]; mx = mx > k ? mx : k; }
                const unsigned mo = (unsigned)__shfl_xor((int)mx, 32); mx = mx > mo ? mx : mo;
                const int j = 63 - (int)(mx & 63u);
                if ((j & 1) == h) keyL[(j >> 1) * 64] = 0u;
                if (j & 1) mask_odd |= 1u << (j >> 1); else mask_even |= 1u << (j >> 1);
            }
        }
    }
    __syncthreads();
    const int nbr = isB ? 3 : 1;
    int lo0, hi0, lo1 = 0, hi1 = 0, lo2 = 0, hi2 = 0;
    const bf16_t *Kb0, *Vb0, *Kb1 = nullptr, *Vb1 = nullptr, *Kb2 = nullptr, *Vb2 = nullptr;
    if (!isB) { lo0 = (t0 - 128) < 0 ? 0 : ((t0 - 128) >> 6); hi0 = thi;
        Kb0 = HM + ((size_t)(8 + g) * M + (size_t)b * 4096) * 64; Vb0 = HM + ((size_t)(10 + g) * M + (size_t)b * 4096) * 64; }
    else { lo0 = 0; hi0 = ctmax; lo1 = 0; hi1 = thi; lo2 = (t0 - 512) < 0 ? 0 : ((t0 - 512) >> 6); hi2 = thi;
        Kb0 = Kc; Vb0 = Vc;
        Kb1 = HM + ((size_t)(32 + g) * M + (size_t)b * 4096) * 64; Vb1 = HM + ((size_t)(34 + g) * M + (size_t)b * 4096) * 64;
        Kb2 = HM + ((size_t)(36 + g) * M + (size_t)b * 4096) * 64; Vb2 = HM + ((size_t)(38 + g) * M + (size_t)b * 4096) * 64; }
    int l_it = 0, l_br = 0, l_tile = lo0, k_issued = 0, kidx = 0;
    const int n_it = isB ? 2 * nbr : 1;
    const int drow = 8 * w + (lane >> 3), dpc = lane & 7;
    const int koff = drow * 64 + ((dpc ^ ((drow >> 1) & 7)) << 3);
    const int voff = drow * 64 + ((dpc ^ (((drow >> 1) & 1) << 2)) << 3);
    LaneC lc;
    { const int kr = lane & 31, i16 = lane & 15, q4 = i16 >> 2, p4 = i16 & 3, g16 = (lane >> 4) & 1, vsw = ((q4 >> 1) & 1) << 3, cb = 4 * g16 + p4;
      lc.kA = kr * 128 + ((h ^ ((kr >> 1) & 7)) << 4);
      lc.vA0 = (4 * h + q4) * 128 + ((cb ^ vsw) << 3); lc.vA1 = (4 * h + q4) * 128 + (((8 + cb) ^ vsw) << 3);
      lc.Xc = 191 - tq + 4 * h; lc.h4 = 4 * h; }
#define ISSUE_INTERVAL() do { if (l_it < n_it) { \
        const bf16_t* kb_ = l_br == 0 ? Kb0 : (l_br == 1 ? Kb1 : Kb2); const bf16_t* vb_ = l_br == 0 ? Vb0 : (l_br == 1 ? Vb1 : Vb2); \
        const int lhi_ = l_br == 0 ? hi0 : (l_br == 1 ? hi1 : hi2); \
        LAS unsigned* dst_ = (LAS unsigned*)(lds + (k_issued & 1) * 32768 + w * 1024); \
        __builtin_amdgcn_global_load_lds((const unsigned*)(kb_ + (size_t)l_tile * 4096 + koff), dst_, 16, 0, 0); \
        __builtin_amdgcn_global_load_lds((const unsigned*)(vb_ + (size_t)l_tile * 4096 + voff), dst_ + 2048, 16, 0, 0); \
        if (l_tile < lhi_) { \
            __builtin_amdgcn_global_load_lds((const unsigned*)(kb_ + (size_t)(l_tile + 1) * 4096 + koff), dst_ + 4096, 16, 0, 0); \
            __builtin_amdgcn_global_load_lds((const unsigned*)(vb_ + (size_t)(l_tile + 1) * 4096 + voff), dst_ + 6144, 16, 0, 0); } \
        l_tile += 2; \
        if (l_tile > lhi_) { ++l_it; l_br = (l_br + 1 == nbr) ? 0 : l_br + 1; l_tile = l_br == 0 ? lo0 : (l_br == 1 ? lo1 : lo2); } } \
        ++k_issued; } while (0)
    ISSUE_INTERVAL();
    bf16x8 qfa[4], qfb[4];
    unsigned* wpk = (unsigned*)wsc;
#pragma unroll 1
    for (int it = 0; it < n_it; ++it) {
        const int hp = isB ? it / 3 : (w >> 2), br = isB ? it - 3 * hp : 0, rA = 2 * hp, rB = 2 * hp + 1;
        const int mode = isB ? br + 1 : 0;
        if (br == 0) { load_q(HM, (isB ? 20 : 0) + 4 * g + rA, m, lane, qfa); load_q(HM, (isB ? 20 : 0) + 4 * g + rB, m, lane, qfb); }
        const int tlo = __builtin_amdgcn_readfirstlane(br == 0 ? lo0 : (br == 1 ? lo1 : lo2)), th = __builtin_amdgcn_readfirstlane(br == 0 ? hi0 : (br == 1 ? hi1 : hi2));
        int hi_t = tq, lo_t = 0; bool bias = true, sel = false, scaled = true;
        int tboffA = L4_TBL0 + rA * 1856, tboffB = L4_TBL0 + rB * 1856; WB wb; wb.hi_min = tq0; wb.hi_max = tq0 + 31; wb.lo_min = 0; wb.lo_max = 0;
        float gateA = 1.f, gateB = 1.f, ccom = 0.f, fA = 1.f, fB = 1.f;
        if (mode == 0) { lo_t = tq - 127; wb.lo_min = tq0 - 127; wb.lo_max = tq0 + 31 - 127; }
        else if (mode == 1) { hi_t = hic_t; bias = false; wb.hi_min = (tq0 - 31) >> 4; wb.hi_max = tq0 >> 4; ccom = ccmp; }
        else if (mode == 2) { sel = true; scaled = false; ccom = TG[3 * 8 * 464 + 25 + 1]; fA = ex2(table_far(tbl0, rA) - ccom); fB = ex2(table_far(tbl0, rB) - ccom); }
        else { tboffA = L4_TBL1 + rA * 1856; tboffB = L4_TBL1 + rB * 1856; scaled = false; ccom = TG[3 * 8 * 464 + 25 + 2];
            fA = ex2(table_far(tbl1, rA) - ccom); fB = ex2(table_far(tbl1, rB) - ccom);
            lo_t = tq - 511; wb.lo_min = tq0 - 511; wb.lo_max = tq0 + 31 - 511; }
        if (isB) { gateA = GB[(size_t)m * 24 + (4 * g + rA) * 3 + br]; gateB = GB[(size_t)m * 24 + (4 * g + rB) * 3 + br]; }
        f32x16 OA[2], OB[2], cin;
#pragma unroll
        for (int i = 0; i < 16; ++i) { OA[0][i] = 0.f; OA[1][i] = 0.f; OB[0][i] = 0.f; OB[1][i] = 0.f; cin[i] = ccom; }
        float lA = 0.f, lB = 0.f;
#pragma unroll 1
        for (int tile0 = tlo; tile0 <= th; tile0 += 2) {
            asm volatile("s_waitcnt vmcnt(0)" ::: "memory");
            __builtin_amdgcn_s_barrier();
            asm volatile("" ::: "memory");
            ISSUE_INTERVAL();
            const int sbase = (kidx & 1) * 32768;
            ++kidx;
#pragma unroll 1
            for (int tt = 0; tt < 2; ++tt) {
                const int tile = tile0 + tt;
                if (tile > th) break;
                const int stoff = sbase + tt * 16384;
                bool any = true;
                if (sel) { const unsigned mk = (tile & 1) ? mask_odd : mask_even; const bool bit = (mk >> (tile >> 1)) & 1u;
                    any = __ballot(bit) != 0ull;
                    if (any) { const float cv = bit ? ccom : -INFINITY;
#pragma unroll
                        for (int i = 0; i < 16; ++i) cin[i] = cv; } }
                if (any) {
#pragma unroll
                    for (int sub = 0; sub < 2; ++sub) {
                        const int k0 = tile * 64 + sub * 32;
                        if (k0 > wb.hi_max || k0 + 31 < wb.lo_min) continue;
                        const bool need_hi = k0 + 31 > wb.hi_min, need_lo = k0 < wb.lo_max;
                        const bool use_tbl = bias && (tq0 - (k0 + 31) < 128);
                        if (use_tbl && !scaled) {
                            scaled = true;
#pragma unroll
                            for (int i = 0; i < 16; ++i) { OA[0][i] *= fA; OA[1][i] *= fA; OB[0][i] *= fB; OB[1][i] *= fB; }
                            lA *= fA; lB *= fB; }
                        subtile2_pv(lds, stoff + sub * 4096, k0, lc, qfa, qfb, OA, OB, lA, lB, cin, -ccom, use_tbl, tboffA, tboffB, need_hi, hi_t, need_lo, lo_t);
                    }
                }
            }
        }
        if (!scaled) { lA *= fA; lB *= fB;
#pragma unroll
            for (int i = 0; i < 16; ++i) { OA[0][i] *= fA; OA[1][i] *= fA; OB[0][i] *= fB; OB[1][i] *= fB; } }
        float la = lA + __shfl_xor(lA, 32), lb = lB + __shfl_xor(lB, 32);
        if (mode == 0) { la += ex2((p.sinks[4 * g + rA] - sc[rA]) * LOG2E); lb += ex2((p.sinks[4 * g + rB] - sc[rB]) * LOG2E); }
        const float sa_ = (la > 0.f ? 1.f / la : 0.f) * gateA, sb_ = (lb > 0.f ? 1.f / lb : 0.f) * gateB;
#pragma unroll
        for (int i = 0; i < 16; ++i) { OA[0][i] *= sa_; OA[1][i] *= sa_; OB[0][i] *= sb_; OB[1][i] *= sb_; }
        if (br != 0) {
#pragma unroll
            for (int i = 0; i < 8; ++i) { const unsigned u0 = wpk[i * 64], u1 = wpk[(8 + i) * 64], v0 = wpk[(16 + i) * 64], v1 = wpk[(24 + i) * 64];
                OA[0][2 * i] += bflo(u0); OA[0][2 * i + 1] += bfhi(u0); OA[1][2 * i] += bflo(u1); OA[1][2 * i + 1] += bfhi(u1);
                OB[0][2 * i] += bflo(v0); OB[0][2 * i + 1] += bfhi(v0); OB[1][2 * i] += bflo(v1); OB[1][2 * i + 1] += bfhi(v1); }
        }
        if (br == nbr - 1) {
            write_y2(Y, HM, (isB ? 40 : 12) + 4 * g + rA, (isB ? 40 : 12) + 4 * g + rB, m, (isB ? 512 : 0) + (4 * g + rA) * 64, (isB ? 512 : 0) + (4 * g + rB) * 64, lane, OA, OB);
        } else {
#pragma unroll
            for (int i = 0; i < 8; ++i) { wpk[i * 64] = pk2(OA[0][2 * i], OA[0][2 * i + 1]); wpk[(8 + i) * 64] = pk2(OA[1][2 * i], OA[1][2 * i + 1]);
                wpk[(16 + i) * 64] = pk2(OB[0][2 * i], OB[0][2 * i + 1]); wpk[(24 + i) * 64] = pk2(OB[1][2 * i], OB[1][2 * i + 1]); }
        }
    }
#undef ISSUE_INTERVAL
    asm volatile("s_waitcnt vmcnt(0)" ::: "memory");
    __syncthreads();
}

DI void phase4(const Params& p, char* lds) {
    unsigned* ctr = (unsigned*)(p.ws + WS_CTL);
    volatile int* su = (volatile int*)(lds + L4_UNIT);
    for (;;) {
        if (threadIdx.x == 0) *su = (int)atomicAdd(ctr, 1u);
        __syncthreads();
        const int u = __builtin_amdgcn_readfirstlane(*su);
        __syncthreads();
        if (u >= 1536) break;
        const bool isB = u < 512; const int uu = isB ? u : u - 512;
        unit(p, isB, uu & 31, (isB ? 15 : 31) - (uu >> 5), lds);
    }
}

__global__ void __launch_bounds__(NTHREADS, 2) fwd_kernel(Params p) {
    extern __shared__ __attribute__((aligned(16))) char lds[];
    const int lo = p.ph_lo, hi = p.ph_hi;
    volatile LAS unsigned* misc = (volatile LAS unsigned*)(LAS char*)(lds + LDS_MISC);
    if (threadIdx.x < 16) misc[threadIdx.x] = 0u;
    __syncthreads();
    XcdBarrier bar = xcd_barrier_post((unsigned*)(p.ws + WS_CTL) + 1024, misc);
#define IN(k) (lo <= (k) && (k) < hi)
#define SEAM(k) do { if (IN((k) + 1)) xcd_barrier(bar); } while (0)
    if (IN(0)) { phase0(p, lds); SEAM(0); }
    if (IN(1)) { phase1(p, lds); SEAM(1); }
    if (IN(2)) {
        pg8::Gemm gm{(const bf16_t*)(p.ws + WS_H), (const bf16_t*)(p.ws + WS_WINT), M, NPADW, 1024};
        pg8::StaticOrder S; S.init(M, NPADW, (int)gridDim.x, (int)blockIdx.x);
        EpiIn E{(bf16_t*)(p.ws + WS_HM), (float*)(p.ws + WS_GB), p.q_gain_a, p.k_gain_a, p.q_gain_b, p.k_gain_sel, p.k_gain_win, p.b_gate};
        pg8::gemm_phase<EpiIn, pg8::StaticOrder, GEMM_ALIGN, GEMM_SP2>((LAS unsigned char*)lds, gm, S, E);
        SEAM(2);
    }
    if (IN(3)) { phase3(p, lds); SEAM(3); }
    if (IN(4)) { phase4(p, lds); SEAM(4); }
    if (IN(5)) {
        pg8::Gemm gm{(const bf16_t*)(p.ws + WS_Y), (const bf16_t*)(p.ws + WS_WOUTT), M, 1024, 1024};
        pg8::StaticOrder S; S.init(M, 1024, (int)gridDim.x, (int)blockIdx.x);
        EpiOut E{p.x, (const float*)(p.ws + WS_MOD), p.out};
        pg8::gemm_phase<EpiOut, pg8::StaticOrder, GEMM_ALIGN, GEMM_SP2>((LAS unsigned char*)lds, gm, S, E);
    }
#undef IN
#undef SEAM
}

extern "C" void kernel_launch(void* const* d_in, const int* in_sizes, int n_in, void* d_out, int out_size, void* d_ws, size_t ws_size, hipStream_t stream) {
    static int grid = 0;
    if (grid == 0) {
        if (n_in != 22 || out_size != M * DM || ws_size < WS_END) { fprintf(stderr, "kernel_launch: unexpected shapes (n_in %d out %d ws %zu need %zu)\n", n_in, out_size, ws_size, (size_t)WS_END); grid = -1; return; }
        int dev = 0, cus = 0, per_cu = 0;
        (void)hipGetDevice(&dev); (void)hipDeviceGetAttribute(&cus, hipDeviceAttributeMultiprocessorCount, dev);
        (void)hipFuncSetAttribute((const void*)fwd_kernel, hipFuncAttributeMaxDynamicSharedMemorySize, LDS_BYTES);
        (void)hipOccupancyMaxActiveBlocksPerMultiprocessor(&per_cu, (const void*)fwd_kernel, NTHREADS, LDS_BYTES);
        if (per_cu < 1) { fprintf(stderr, "kernel_launch: occupancy query says %d blocks/CU\n", per_cu); grid = -1; return; }
        grid = cus;
        fprintf(stderr, "kernel_launch: cus %d per_cu %d grid %d\n", cus, per_cu, grid);
    }
    if (grid < 0) return;
    (void)hipMemsetAsync((char*)d_ws + WS_CTL, 0, CTL_BYTES, stream);
    Params p{};
    const float** pin = (const float**)&p;
    for (int i = 0; i < 22; ++i) pin[i] = (const float*)d_in[i];
    p.out = (float*)d_out; p.ws = (unsigned char*)d_ws;
#if N_LAUNCHES == 1
    p.ph_lo = 0; p.ph_hi = 6;
    void* args[] = {&p};
    hipError_t e = hipLaunchCooperativeKernel((const void*)fwd_kernel, dim3(grid), dim3(NTHREADS), args, LDS_BYTES, stream);
    if (e != hipSuccess) fprintf(stderr, "cooperative launch failed: %s (grid %d)\n", hipGetErrorString(e), grid);
#else
    for (int ph = 0; ph < 6; ++ph) { p.ph_lo = ph; p.ph_hi = ph + 1; hipLaunchKernelGGL(fwd_kernel, dim3(grid), dim3(NTHREADS), LDS_BYTES, stream, p); }
#endif
}
```

```cpp
#include <hip/hip_runtime.h>
#include <cstdio>
#include <cstdint>

#ifndef GEMM_ALIGN
#define GEMM_ALIGN true
#endif
#ifndef GEMM_SP2
#define GEMM_SP2 true
#endif
#ifndef N_LAUNCHES
#define N_LAUNCHES 1
#endif

#define DI __device__ __forceinline__
#define LAS __attribute__((address_space(3)))
typedef unsigned short bf16_t;
typedef short bf16x8 __attribute__((ext_vector_type(8)));
typedef short s16x4 __attribute__((ext_vector_type(4)));
typedef float f32x2 __attribute__((ext_vector_type(2)));
typedef float f32x4 __attribute__((ext_vector_type(4)));
typedef float f32x16 __attribute__((ext_vector_type(16)));
typedef unsigned u32x2 __attribute__((ext_vector_type(2)));
typedef unsigned u32x4 __attribute__((ext_vector_type(4)));
typedef __bf16 bf16x2v __attribute__((ext_vector_type(2)));

constexpr int NBATCH = 16, SEQ = 4096, M = NBATCH * SEQ, DM = 1024, NPROJ = 3096, NPADW = 3072;
constexpr float EPS = 1e-6f, LOG2E = 1.4426950408889634f;
constexpr size_t MiB = 1u << 20;
constexpr size_t WS_CTL = 0;
constexpr size_t CTL_BYTES = 32768;
constexpr size_t WS_MOD = 1 * MiB;
constexpr size_t WS_BIAS1 = WS_MOD + 256 * 1024;
constexpr size_t WS_TBL = WS_MOD + 512 * 1024;
constexpr size_t WS_W2T = 2 * MiB;
constexpr size_t WS_W1T = 3 * MiB;
constexpr size_t WS_WOUTT = 5 * MiB;
constexpr size_t WS_WINT = 7 * MiB;
constexpr size_t WS_KCMP = 14 * MiB;
constexpr size_t WS_VCMP = 15 * MiB;
constexpr size_t WS_GB = 16 * MiB;
constexpr size_t WS_H = 32 * MiB;
constexpr size_t WS_Y = 160 * MiB;
constexpr size_t WS_HM = 288 * MiB;
constexpr size_t WS_END = WS_HM + (size_t)48 * M * 64 * 2;
constexpr int LDS_BYTES = 148992;
constexpr int LDS_MISC = 148480;
constexpr int NTHREADS = 512;

struct Params {
    const float *x, *c, *w_ada, *b_ada, *norm_gain, *w_in, *b_gate, *q_gain_a, *k_gain_a, *sinks, *q_gain_b,
        *k_gain_cmp, *k_gain_sel, *k_gain_win, *cmp_pos_k, *cmp_pos_v, *w_cmp_k1, *w_cmp_k2, *w_cmp_v1, *w_cmp_v2, *w_out, *rel_bias;
    float* out; unsigned char* ws; int ph_lo, ph_hi;
};

DI unsigned pk2(float lo, float hi) { f32x2 v = {lo, hi}; bf16x2v b = __builtin_convertvector(v, bf16x2v); return __builtin_bit_cast(unsigned, b); }
DI float bflo(unsigned u) { return __builtin_bit_cast(float, u << 16); }
DI float bfhi(unsigned u) { return __builtin_bit_cast(float, u & 0xffff0000u); }
DI float ex2(float x) { return __builtin_amdgcn_exp2f(x); }
DI float rsq(float x) { return __builtin_amdgcn_rsqf(x); }
DI float sigm(float x) { return __builtin_amdgcn_rcpf(1.f + __builtin_amdgcn_exp2f(x * -LOG2E)); }
DI float wave_sum(float v) {
#pragma unroll
    for (int o = 1; o < 64; o <<= 1) v += __shfl_xor(v, o);
    return v;
}
DI f32x4 mfma16(bf16x8 a, bf16x8 b, f32x4 c) { return __builtin_amdgcn_mfma_f32_16x16x32_bf16(a, b, c, 0, 0, 0); }
DI f32x16 mfma32(bf16x8 a, bf16x8 b, f32x16 c) { return __builtin_amdgcn_mfma_f32_32x32x16_bf16(a, b, c, 0, 0, 0); }
DI int t5_bucket(int n) {
    if (n < 16) return n < 0 ? 0 : n;
    int b = 16;
    b += (n >= 19); b += (n >= 21); b += (n >= 24); b += (n >= 27); b += (n >= 31); b += (n >= 35); b += (n >= 40); b += (n >= 46);
    b += (n >= 52); b += (n >= 59); b += (n >= 67); b += (n >= 77); b += (n >= 87); b += (n >= 99); b += (n >= 113);
    return b;
}

#define XB_TMO      128
#define XB_XCNT(j)  (256  + 64 * (j))
#define XB_XSUB(j)  (1280 + 64 * (j))
#define XB_XGEN(j)  (2304 + 64 * (j))
#define XB_TOP      3328
#define XB_TOPGEN   3392
#define XCD_BAR_WORDS 3456
#define XB_SPIN_CAP (1u << 18)
DI unsigned xb_ld(unsigned* p)              { return __hip_atomic_load(p, __ATOMIC_RELAXED, __HIP_MEMORY_SCOPE_AGENT); }
DI unsigned xb_add(unsigned* p, unsigned v) { return __hip_atomic_fetch_add(p, v, __ATOMIC_RELAXED, __HIP_MEMORY_SCOPE_AGENT); }
DI unsigned xb_xcc_id() { return (unsigned)__builtin_amdgcn_s_getreg((3 << 11) | 20) & 0xFu; }
#define XB_SPIN(cond, bar) do { unsigned _sp = 0; while (cond) { __builtin_amdgcn_s_sleep(1); \
    if ((++_sp & 255u) == 0u) { if (xb_ld(&(bar)[XB_TMO])) break; if (_sp > XB_SPIN_CAP) { atomicAdd(&(bar)[XB_TMO], 1u); break; } } } } while (0)
struct XcdBarrier { unsigned* bar; unsigned x; volatile LAS unsigned* st; };
DI XcdBarrier xcd_barrier_post(unsigned* bar, volatile LAS unsigned* st) {
    XcdBarrier b; b.bar = bar; b.x = xb_xcc_id(); b.st = st;
    if (threadIdx.x == 0) (void)xb_add(&bar[XB_XCNT(b.x)], 1u);
    return b;
}
DI void xcd_barrier_complete(unsigned* bar, unsigned x, unsigned& nloc, unsigned& nx) {
    const unsigned G = gridDim.x * gridDim.y * gridDim.z;
    unsigned sum, cnt, mine, sp = 0u;
    for (;;) {
        sum = 0u; cnt = 0u; mine = 0u;
#pragma unroll
        for (unsigned j = 0; j < 16; ++j) { const unsigned c = xb_ld(&bar[XB_XCNT(j)]); sum += c; cnt += (c > 0u) ? 1u : 0u; mine = (j == x) ? c : mine; }
        if (sum == G) break;
        __builtin_amdgcn_s_sleep(1);
        if ((++sp & 255u) == 0u) { if (xb_ld(&bar[XB_TMO])) break; if (sp > XB_SPIN_CAP) { atomicAdd(&bar[XB_TMO], 1u); break; } }
    }
    nloc = mine > 0u ? mine : 1u; nx = cnt > 0u ? cnt : 1u;
}
DI void xcd_barrier(const XcdBarrier& b) {
    asm volatile("s_waitcnt vmcnt(0)" ::: "memory");
    __syncthreads();
    if (threadIdx.x == 0) {
        unsigned* bar = b.bar;
        __builtin_amdgcn_s_waitcnt(0);
        unsigned nloc = b.st[0], nx = b.st[1];
        if (nloc == 0u) { xcd_barrier_complete(bar, b.x, nloc, nx); b.st[0] = nloc; b.st[1] = nx; }
        const unsigned old = xb_add(&bar[XB_XSUB(b.x)], 1u);
        const unsigned gen = old / nloc;
        if (old + 1u == (gen + 1u) * nloc) {
            __builtin_amdgcn_fence(__ATOMIC_RELEASE, "agent");
            asm volatile("s_waitcnt vmcnt(0)" ::: "memory");
            const unsigned og = xb_add(&bar[XB_TOP], 1u);
            const unsigned tg = og / nx;
            if (og + 1u == (tg + 1u) * nx) xb_add(&bar[XB_TOPGEN], 1u);
            else XB_SPIN(xb_ld(&bar[XB_TOPGEN]) == tg, bar);
            __builtin_amdgcn_fence(__ATOMIC_ACQUIRE, "agent");
            xb_add(&bar[XB_XGEN(b.x)], 1u);
            asm volatile("s_waitcnt vmcnt(0)" ::: "memory");
        } else {
            XB_SPIN(xb_ld(&bar[XB_XGEN(b.x)]) == gen, bar);
            __builtin_amdgcn_fence(__ATOMIC_ACQUIRE, "agent");
            asm volatile("s_waitcnt vmcnt(0)" ::: "memory");
        }
    }
    __syncthreads();
}

namespace pg8 {
constexpr int BM = 256, BK = 64, HALF = 128, HTB = HALF * BK * 2, STAGE_BYTES = 8 * HTB, NXCD = 8, WGM = 8;
__host__ __device__ __forceinline__ int lds_byte(int r, int c) { const int st = (r >> 4) * 2 + (c >> 5), rr = r & 15, cc = c & 31, ob = rr * 64 + cc * 2; return st * 1024 + (ob ^ (((ob >> 9) & 1) << 5)); }
__host__ __device__ __forceinline__ void stage_rc(int b, int& R, int& C) { const int st = b / 1024, sb = b % 1024, swz = sb ^ (((sb >> 9) & 1) << 5); R = (st >> 1) * 16 + swz / 64; C = (st & 1) * 32 + (swz % 64) / 2; }
__host__ __device__ __forceinline__ int perm32(int rho) { const int n = rho >> 4, i = rho & 15; return 8 * (i >> 2) + 4 * n + (i & 3); }
struct Unit { int pm, pn; };
struct Gemm { const bf16_t* A; const bf16_t* Bt; int M, N, K; };
struct StaticOrder {
    int nM, nN, nwg, G, c;
    __host__ __device__ void init(int M_, int N_, int G_, int c_) { nM = M_ / BM; nN = N_ / BM; nwg = nM * nN; G = G_; c = c_; }
    __host__ __device__ bool next(int i, Unit& u) const {
        const long L = (long)i * G + c; if (L >= nwg) return false;
        int wgid = (int)L; { const int q = nwg / NXCD, r = nwg % NXCD, xcd = wgid % NXCD, off = wgid / NXCD; wgid = (xcd < r ? xcd * (q + 1) : r * (q + 1) + (xcd - r) * q) + off; }
        const int nig = WGM * nN, gid = wgid / nig, fm = gid * WGM, gsz = (nM - fm) < WGM ? (nM - fm) : WGM;
        u.pm = fm + ((wgid % nig) % gsz); u.pn = (wgid % nig) / gsz; return true;
    }
};
template <class Epi, class Sched, bool ALIGN_EPI, bool SP2>
__device__ __forceinline__ void gemm_phase(LAS unsigned char* lds, const Gemm g, const Sched& S, const Epi& E) {
    const int tid = threadIdx.x, wid = __builtin_amdgcn_readfirstlane(tid >> 6), lane = tid & 63, wr = wid >> 2, wc = wid & 3, fr = lane & 15, fq = lane >> 4;
    const int K = g.K, nt = K / BK;
    unsigned voffA[2], voffB[2];
#pragma unroll
    for (int i = 0; i < 2; ++i) { int R, C; stage_rc(tid * 16 + i * 8192, R, C); const int Rb = Epi::brow(R);
        voffA[i] = (unsigned)(R * K + C) * 2u; voffB[i] = (unsigned)(Rb * K + C) * 2u; }
    const size_t kstep = (size_t)(BK * 2);
    const size_t hstep = (size_t)HALF * K * 2;
    const size_t hstepB = (size_t)Epi::BHALF * K * 2;
    const size_t tstep = 2 * hstep;
    const unsigned ldsw = (unsigned)wid * 1024u;
    const int aoff = lds_byte(wr * 64 + fr, fq * 8), boff = lds_byte(wc * 32 + fr, fq * 8);
#define PG8_SA(b, h) (((b) * 2 + (h)) * HTB)
#define PG8_SB(b, h) ((4 + (b) * 2 + (h)) * HTB)
#define PG8_STAGE(bufoff, gbase, voff) do { _Pragma("unroll") for (int _i = 0; _i < 2; ++_i) \
        __builtin_amdgcn_global_load_lds((const unsigned*)((const char*)(gbase) + (voff)[_i]), (LAS unsigned*)(lds + (bufoff) + ldsw + _i * 8192), 16, 0, 0); } while (0)
#define PG8_LDA(dst, b, h) do { _Pragma("unroll") for (int m = 0; m < 4; ++m) _Pragma("unroll") for (int k = 0; k < 2; ++k) dst[m][k] = *(const LAS bf16x8*)(lds + PG8_SA(b, h) + aoff + m * 2048 + k * 1024); } while (0)
#define PG8_LDB(dst, b, h) do { _Pragma("unroll") for (int n = 0; n < 2; ++n) _Pragma("unroll") for (int k = 0; k < 2; ++k) dst[n][k] = *(const LAS bf16x8*)(lds + PG8_SB(b, h) + boff + n * 2048 + k * 1024); } while (0)
#define PG8_MMA(ai, bj, At, Bt) do { __builtin_amdgcn_s_setprio(1); _Pragma("unroll") for (int m = 0; m < 4; ++m) _Pragma("unroll") for (int n = 0; n < 2; ++n) _Pragma("unroll") for (int k = 0; k < 2; ++k) \
        acc[ai][bj][m][n] = __builtin_amdgcn_mfma_f32_16x16x32_bf16(Bt[n][k], At[m][k], acc[ai][bj][m][n], 0, 0, 0); __builtin_amdgcn_s_setprio(0); } while (0)
#define PG8_WAIT_V(n) asm volatile("s_waitcnt vmcnt(" #n ")" ::: "memory")
#define PG8_WAIT_L(n) asm volatile("s_waitcnt lgkmcnt(" #n ")" ::: "memory")
#define PG8_BAR __builtin_amdgcn_s_barrier()
#define PG8_SCHED __builtin_amdgcn_sched_barrier(0)
    Unit cur, nxt; int ui = 0;
    if (!S.next(0, cur)) return;
    f32x4 acc[2][2][4][2];
#pragma unroll
    for (int a = 0; a < 2; ++a)
#pragma unroll
        for (int b = 0; b < 2; ++b)
#pragma unroll
            for (int m = 0; m < 4; ++m)
#pragma unroll
                for (int n = 0; n < 2; ++n) acc[a][b][m][n] = (f32x4){0.f, 0.f, 0.f, 0.f};
    bf16x8 At[4][2], B0[2][2], B1[2][2];
    const char* cA = (const char*)g.A + (size_t)cur.pm * tstep; const char* cB = (const char*)g.Bt + (size_t)cur.pn * tstep;
    if constexpr (SP2) {
        PG8_STAGE(PG8_SB(0, 0), cB, voffB); PG8_STAGE(PG8_SB(0, 1), cB + hstepB, voffB); PG8_STAGE(PG8_SA(0, 0), cA, voffA); PG8_STAGE(PG8_SA(0, 1), cA + hstep, voffA);
        if (wr == 1) PG8_BAR;
        PG8_WAIT_V(2); PG8_BAR;
        PG8_STAGE(PG8_SB(1, 0), cB + kstep, voffB); PG8_STAGE(PG8_SA(1, 0), cA + kstep, voffA); PG8_STAGE(PG8_SB(1, 1), cB + hstepB + kstep, voffB);
        PG8_WAIT_V(6); PG8_BAR;
    } else {
        PG8_STAGE(PG8_SB(0, 0), cB, voffB); PG8_STAGE(PG8_SA(0, 0), cA, voffA); PG8_STAGE(PG8_SB(0, 1), cB + hstepB, voffB); PG8_STAGE(PG8_SA(0, 1), cA + hstep, voffA);
        if (wr == 1) PG8_BAR;
        PG8_WAIT_V(4); PG8_BAR;
        PG8_STAGE(PG8_SB(1, 0), cB + kstep, voffB); PG8_STAGE(PG8_SA(1, 0), cA + kstep, voffA); PG8_STAGE(PG8_SB(1, 1), cB + hstepB + kstep, voffB);
        PG8_WAIT_V(6); PG8_BAR;
    }
    for (;;) {
        const bool has_next = S.next(ui + 1, nxt);
        const char* nA = has_next ? (const char*)g.A + (size_t)nxt.pm * tstep : cA; const char* nB = has_next ? (const char*)g.Bt + (size_t)nxt.pn * tstep : cB;
        for (int t = 0; t < nt; t += 2) {
            const bool last = (t == nt - 2);
            const char* a1 = cA + (size_t)(t + 1) * kstep;
            const char* a2 = last ? nA : cA + (size_t)(t + 2) * kstep; const char* b2 = last ? nB : cB + (size_t)(t + 2) * kstep;
            const char* a3 = a2 + kstep; const char* b3 = b2 + kstep;
            if constexpr (SP2) {
            PG8_LDB(B0, 0, 0); PG8_LDB(B1, 0, 1); PG8_SCHED; PG8_LDA(At, 0, 0); PG8_STAGE(PG8_SA(1, 1), a1 + hstep, voffA);
            PG8_WAIT_V(8); PG8_WAIT_L(0); PG8_BAR; PG8_MMA(0, 0, At, B0); PG8_MMA(0, 1, At, B1); PG8_BAR; PG8_SCHED;
            PG8_LDA(At, 0, 1); PG8_STAGE(PG8_SB(0, 0), b2, voffB); PG8_STAGE(PG8_SB(0, 1), b2 + hstepB, voffB); PG8_STAGE(PG8_SA(0, 0), a2, voffA);
            PG8_WAIT_V(8); PG8_WAIT_L(0); PG8_BAR; PG8_MMA(1, 0, At, B0); PG8_MMA(1, 1, At, B1); PG8_BAR; PG8_SCHED;
            PG8_LDB(B0, 1, 0); PG8_LDB(B1, 1, 1); PG8_SCHED; PG8_LDA(At, 1, 0); PG8_STAGE(PG8_SA(0, 1), a2 + hstep, voffA);
            PG8_WAIT_V(8); PG8_WAIT_L(0); PG8_BAR; PG8_MMA(0, 0, At, B0); PG8_MMA(0, 1, At, B1); PG8_BAR; PG8_SCHED;
            PG8_LDA(At, 1, 1); PG8_STAGE(PG8_SB(1, 0), b3, voffB); PG8_STAGE(PG8_SB(1, 1), b3 + hstepB, voffB); PG8_STAGE(PG8_SA(1, 0), a3, voffA);
            PG8_WAIT_V(8); PG8_WAIT_L(0); PG8_BAR; PG8_MMA(1, 0, At, B0); PG8_MMA(1, 1, At, B1); PG8_BAR; PG8_SCHED;
            } else {
            PG8_LDB(B0, 0, 0); PG8_SCHED; PG8_LDA(At, 0, 0); PG8_STAGE(PG8_SA(1, 1), a1 + hstep, voffA);
            PG8_WAIT_L(8); PG8_BAR; PG8_WAIT_L(0); PG8_MMA(0, 0, At, B0); PG8_BAR; PG8_SCHED;
            PG8_LDB(B1, 0, 1); PG8_STAGE(PG8_SB(0, 0), b2, voffB);
            PG8_BAR; PG8_WAIT_L(0); PG8_MMA(0, 1, At, B1); PG8_BAR;
            PG8_LDA(At, 0, 1); PG8_STAGE(PG8_SA(0, 0), a2, voffA);
            PG8_BAR; PG8_WAIT_L(0); PG8_MMA(1, 0, At, B0); PG8_BAR; PG8_SCHED;
            PG8_STAGE(PG8_SB(0, 1), b2 + hstepB, voffB);
            PG8_WAIT_V(6); PG8_BAR; PG8_MMA(1, 1, At, B1); PG8_BAR;
            PG8_LDB(B0, 1, 0); PG8_SCHED; PG8_LDA(At, 1, 0); PG8_STAGE(PG8_SA(0, 1), a2 + hstep, voffA);
            PG8_WAIT_L(8); PG8_BAR; PG8_WAIT_L(0); PG8_MMA(0, 0, At, B0); PG8_BAR; PG8_SCHED;
            PG8_LDB(B1, 1, 1); PG8_STAGE(PG8_SB(1, 0), b3, voffB);
            PG8_BAR; PG8_WAIT_L(0); PG8_MMA(0, 1, At, B1); PG8_BAR;
            PG8_LDA(At, 1, 1); PG8_STAGE(PG8_SA(1, 0), a3, voffA);
            PG8_BAR; PG8_WAIT_L(0); PG8_MMA(1, 0, At, B0); PG8_BAR; PG8_SCHED;
            PG8_STAGE(PG8_SB(1, 1), b3 + hstepB, voffB);
            PG8_WAIT_V(6); PG8_BAR; PG8_MMA(1, 1, At, B1); PG8_BAR;
            }
        }
        if constexpr (ALIGN_EPI) { if (wr == 0) PG8_BAR; }
        E(acc, cur, wr, wc, fr, fq);
        if (!has_next) break;
#pragma unroll
        for (int a = 0; a < 2; ++a)
#pragma unroll
            for (int b = 0; b < 2; ++b)
#pragma unroll
                for (int m = 0; m < 4; ++m)
#pragma unroll
                    for (int n = 0; n < 2; ++n) acc[a][b][m][n] = (f32x4){0.f, 0.f, 0.f, 0.f};
        cur = nxt; cA = nA; cB = nB; ++ui;
        if constexpr (ALIGN_EPI) { if (wr == 1) PG8_BAR; }
    }
    PG8_WAIT_V(0);
    if constexpr (!ALIGN_EPI) { if (wr == 0) PG8_BAR; }
    PG8_BAR;
#undef PG8_SA
#undef PG8_SB
#undef PG8_STAGE
#undef PG8_LDA
#undef PG8_LDB
#undef PG8_MMA
#undef PG8_WAIT_V
#undef PG8_WAIT_L
#undef PG8_BAR
#undef PG8_SCHED
}
}

struct EpiIn {
    static constexpr int BHALF = 32;
    __host__ __device__ static int brow(int R) { return 64 * (R >> 5) + pg8::perm32(R & 31); }
    bf16_t* HM; float* GB; const float *q_gain_a, *k_gain_a, *q_gain_b, *k_gain_sel, *k_gain_win, *b_gate;
    DI void operator()(const f32x4 (&acc)[2][2][4][2], const pg8::Unit& u, int wr, int wc, int fr, int fq) const {
        const int row0 = u.pm * 256 + wr * 64 + fr;
        const int slot = u.pn * 4 + wc;
        bf16_t* base = HM + ((size_t)slot * M + row0) * 64 + 8 * fq;
        const float* gain = nullptr; float extra = 1.f; int kind = 0;
        if (slot < 8) { gain = q_gain_a; extra = 0.125f * LOG2E; kind = 1; }
        else if (slot < 10) { gain = k_gain_a; kind = 1; }
        else if (slot < 12) kind = 0;
        else if (slot < 20) kind = 2;
        else if (slot < 28) { gain = q_gain_b; extra = 0.125f * LOG2E; kind = 1; }
        else if (slot < 32) kind = 0;
        else if (slot < 34) { gain = k_gain_sel; kind = 1; }
        else if (slot < 36) kind = 0;
        else if (slot < 38) { gain = k_gain_win; kind = 1; }
        else if (slot < 40) kind = 0;
        else kind = 2;
        if (kind == 1) {
            f32x4 gv[2][2];
#pragma unroll
            for (int bj = 0; bj < 2; ++bj)
#pragma unroll
                for (int n = 0; n < 2; ++n) gv[bj][n] = *(const f32x4*)(gain + 32 * bj + 8 * fq + 4 * n);
#pragma unroll
            for (int ai = 0; ai < 2; ++ai)
#pragma unroll
                for (int m = 0; m < 4; ++m) {
                    float ss = 0.f;
#pragma unroll
                    for (int bj = 0; bj < 2; ++bj)
#pragma unroll
                        for (int n = 0; n < 2; ++n) { const f32x4 a = acc[ai][bj][m][n]; ss += (a.x * a.x + a.y * a.y) + (a.z * a.z + a.w * a.w); }
                    ss += __shfl_xor(ss, 16); ss += __shfl_xor(ss, 32);
                    const float rs = rsq(ss * (1.f / 64.f) + EPS) * extra;
#pragma unroll
                    for (int bj = 0; bj < 2; ++bj) { const f32x4 v0 = acc[ai][bj][m][0] * rs * gv[bj][0], v1 = acc[ai][bj][m][1] * rs * gv[bj][1];
                        u32x4 w; w.x = pk2(v0.x, v0.y); w.y = pk2(v0.z, v0.w); w.z = pk2(v1.x, v1.y); w.w = pk2(v1.z, v1.w);
                        *(u32x4*)(base + (size_t)(ai * 128 + m * 16) * 64 + 32 * bj) = w; }
                }
        } else {
#pragma unroll
            for (int ai = 0; ai < 2; ++ai)
#pragma unroll
                for (int m = 0; m < 4; ++m)
#pragma unroll
                    for (int bj = 0; bj < 2; ++bj) { f32x4 v0 = acc[ai][bj][m][0], v1 = acc[ai][bj][m][1];
                        if (kind == 2) { v0.x *= sigm(v0.x); v0.y *= sigm(v0.y); v0.z *= sigm(v0.z); v0.w *= sigm(v0.w);
                                         v1.x *= sigm(v1.x); v1.y *= sigm(v1.y); v1.z *= sigm(v1.z); v1.w *= sigm(v1.w); }
                        u32x4 w; w.x = pk2(v0.x, v0.y); w.y = pk2(v0.z, v0.w); w.z = pk2(v1.x, v1.y); w.w = pk2(v1.z, v1.w);
                        *(u32x4*)(base + (size_t)(ai * 128 + m * 16) * 64 + 32 * bj) = w; }
        }
    }
};
struct EpiOut {
    static constexpr int BHALF = 128;
    __host__ __device__ static int brow(int R) { return R; }
    const float* x; const float* mod; float* out;
    DI void operator()(const f32x4 (&acc)[2][2][4][2], const pg8::Unit& u, int wr, int wc, int fr, int fq) const {
        const int row0 = u.pm * 256 + wr * 64 + fr, col0 = u.pn * 256 + wc * 32 + 4 * fq;
        const float* gate = mod + (u.pm >> 4) * 3072 + 2048 + col0;
        f32x4 gv[2][2];
#pragma unroll
        for (int bj = 0; bj < 2; ++bj)
#pragma unroll
            for (int n = 0; n < 2; ++n) gv[bj][n] = *(const f32x4*)(gate + bj * 128 + n * 16);
        f32x4 xa[2][2][2], xb[2][2][2];
#define EO_OFF(q, mm) ((size_t)(row0 + ((q) >> 1) * 128 + (((q) & 1) * 2 + (mm)) * 16) * 1024 + col0)
#define EO_LOAD(XV, q) do { _Pragma("unroll") for (int mm = 0; mm < 2; ++mm) _Pragma("unroll") for (int bj = 0; bj < 2; ++bj) _Pragma("unroll") for (int n = 0; n < 2; ++n) \
            XV[mm][bj][n] = *(const f32x4*)(x + EO_OFF(q, mm) + bj * 128 + n * 16); } while (0)
#define EO_STORE(XV, q) do { _Pragma("unroll") for (int mm = 0; mm < 2; ++mm) _Pragma("unroll") for (int bj = 0; bj < 2; ++bj) _Pragma("unroll") for (int n = 0; n < 2; ++n) \
            *(f32x4*)(out + EO_OFF(q, mm) + bj * 128 + n * 16) = XV[mm][bj][n] + gv[bj][n] * acc[(q) >> 1][bj][((q) & 1) * 2 + mm][n]; } while (0)
        __builtin_amdgcn_s_waitcnt(0x0F70);
        EO_LOAD(xa, 0);
        __builtin_amdgcn_sched_barrier(0);
        EO_LOAD(xb, 1);
        __builtin_amdgcn_sched_barrier(0);
        EO_STORE(xa, 0);
        __builtin_amdgcn_sched_barrier(0);
        EO_LOAD(xa, 2);
        __builtin_amdgcn_sched_barrier(0);
        EO_STORE(xb, 1);
        __builtin_amdgcn_sched_barrier(0);
        EO_LOAD(xb, 3);
        __builtin_amdgcn_sched_barrier(0);
        EO_STORE(xa, 2);
        EO_STORE(xb, 3);
        asm volatile("" ::: "memory");
#undef EO_OFF
#undef EO_LOAD
#undef EO_STORE
    }
};

DI void p0_mod_a(const Params& p, char* lds, int ht) {
    float* sc = (float*)lds;
    for (int i = ht; i < 16384; i += 256) { const int b = i >> 10, k = i & 1023; const float cv = p.c[i]; sc[k * 16 + b] = cv * sigm(cv); }
}
DI void p0_mod_b(const Params& p, int item, char* lds, int ht) {
    const int col = ht & 15, kg = ht >> 4, n0 = item * 16;
    const float* sc = (const float*)lds; float* red = (float*)(lds + 65536);
    float acc[16];
#pragma unroll
    for (int b = 0; b < 16; ++b) acc[b] = 0.f;
#pragma unroll 1
    for (int c = 0; c < 4; ++c) {
        float wv[16];
#pragma unroll
        for (int kk = 0; kk < 16; ++kk) wv[kk] = p.w_ada[(size_t)(kg * 64 + c * 16 + kk) * 3072 + n0 + col];
#pragma unroll 4
        for (int kk = 0; kk < 16; ++kk) {
            const int k = kg * 64 + c * 16 + kk;
            const float w = wv[kk];
            const f32x4* s4 = (const f32x4*)(sc + k * 16);
#pragma unroll
            for (int q = 0; q < 4; ++q) { const f32x4 s = s4[q]; acc[4 * q] += s.x * w; acc[4 * q + 1] += s.y * w; acc[4 * q + 2] += s.z * w; acc[4 * q + 3] += s.w * w; }
        }
    }
#pragma unroll
    for (int b = 0; b < 16; ++b) { float a = acc[b]; a += __shfl_xor(a, 16); a += __shfl_xor(a, 32); if ((ht & 63) < 16) red[((ht >> 6) * 16 + b) * 16 + col] = a; }
}
DI void p0_mod_c(const Params& p, int item, char* lds, int ht, float* mod) {
    const int col = ht & 15, b = ht >> 4, n0 = item * 16; const float* red = (const float*)(lds + 65536);
    const float s = (red[(0 * 16 + b) * 16 + col] + red[(1 * 16 + b) * 16 + col]) + (red[(2 * 16 + b) * 16 + col] + red[(3 * 16 + b) * 16 + col]);
    mod[b * 3072 + n0 + col] = s + p.b_ada[n0 + col];
}
DI void p0_tr_a(const float* src, int N, int kb, int nb, char* lds, int ht) {
    float* t = (float*)lds; const int k0 = kb * 64, n0 = nb * 64;
#pragma unroll 4
    for (int i = 0; i < 16; ++i) { const int r = i * 4 + (ht >> 6), cc = ht & 63;
        t[r * 65 + cc] = (n0 + cc < N) ? src[(size_t)(k0 + r) * N + n0 + cc] : 0.f; }
}
DI void p0_tr_b(bf16_t* dst, int K, int kb, int nb, char* lds, int ht) {
    const float* t = (const float*)lds; const int k0 = kb * 64, n0 = nb * 64, n = ht >> 2, kc = (ht & 3) * 16;
    u32x4 o0, o1;
    o0.x = pk2(t[(kc + 0) * 65 + n], t[(kc + 1) * 65 + n]); o0.y = pk2(t[(kc + 2) * 65 + n], t[(kc + 3) * 65 + n]);
    o0.z = pk2(t[(kc + 4) * 65 + n], t[(kc + 5) * 65 + n]); o0.w = pk2(t[(kc + 6) * 65 + n], t[(kc + 7) * 65 + n]);
    o1.x = pk2(t[(kc + 8) * 65 + n], t[(kc + 9) * 65 + n]); o1.y = pk2(t[(kc + 10) * 65 + n], t[(kc + 11) * 65 + n]);
    o1.z = pk2(t[(kc + 12) * 65 + n], t[(kc + 13) * 65 + n]); o1.w = pk2(t[(kc + 14) * 65 + n], t[(kc + 15) * 65 + n]);
    u32x4* d = (u32x4*)(dst + (size_t)(n0 + n) * K + k0 + kc); d[0] = o0; d[1] = o1;
}
DI void p0_b1_a(const Params& p, int item, char* lds, int ht) {
    const int kv = item >> 2, n0 = (item & 3) * 64, col = ht & 63, kg = ht >> 6;
    const float* pos = kv ? p.cmp_pos_v : p.cmp_pos_k; const float* w1 = kv ? p.w_cmp_v1 : p.w_cmp_k1;
    float a = 0.f;
#pragma unroll 8
    for (int kk = 0; kk < 512; ++kk) { const int k = kg * 512 + kk; a += pos[k] * w1[(size_t)k * 256 + n0 + col]; }
    ((float*)lds)[kg * 64 + col] = a;
}
DI void p0_b1_b(int item, char* lds, int ht, float* bias1) {
    const float* red = (const float*)lds; const int kv = item >> 2, n0 = (item & 3) * 64;
    if (ht < 64) bias1[kv * 256 + n0 + ht] = (red[ht] + red[64 + ht]) + (red[128 + ht] + red[192 + ht]);
}
DI void p0_tbl(const Params& p, int kind, int ht, float* T) {
    const float* gq = kind == 0 ? p.q_gain_a : p.q_gain_b; const float* gk = kind == 0 ? p.k_gain_a : (kind == 1 ? p.k_gain_sel : p.k_gain_win);
    const int head0 = kind == 0 ? 0 : 8;
    float gm = 0.f;
    for (int d = 0; d < 64; ++d) gm = fmaxf(gm, fabsf(gq[d] * gk[d]));
    for (int idx = ht; idx < 8 * 464; idx += 256) { const int r = idx / 464, rem = idx - r * 464, cp = rem / 232, i = rem - cp * 232;
        int dist = 191 - i - cp; dist = dist < 0 ? 0 : (dist > 128 ? 128 : dist);
        float bm = 0.f;
        for (int bk = 0; bk < 32; ++bk) bm = fmaxf(bm, p.rel_bias[bk * 16 + head0 + r]);
        const float shift = 8.f * gm + bm;
        T[(kind * 8 + r) * 464 + rem] = (p.rel_bias[t5_bucket(dist) * 16 + head0 + r] - shift) * LOG2E;
        if (rem == 0) T[3 * 8 * 464 + kind * 8 + r] = shift; }
    if (ht == 0) T[3 * 8 * 464 + 25 + kind] = -8.f * gm * LOG2E;
    if (kind == 0 && ht == 0) { float gc = 0.f; for (int d = 0; d < 64; ++d) gc = fmaxf(gc, fabsf(p.q_gain_b[d] * p.k_gain_cmp[d])); T[3 * 8 * 464 + 24] = -8.f * gc * LOG2E; }
}
DI void phase0(const Params& p, char* lds0) {
    float* mod = (float*)(p.ws + WS_MOD); float* bias1 = (float*)(p.ws + WS_BIAS1);
    bf16_t* WinT = (bf16_t*)(p.ws + WS_WINT); bf16_t* WoutT = (bf16_t*)(p.ws + WS_WOUTT);
    bf16_t* W1T = (bf16_t*)(p.ws + WS_W1T); bf16_t* W2T = (bf16_t*)(p.ws + WS_W2T);
    constexpr int I_MOD = 192, I_TBL = 3, I_B1 = 8, I_WIN = 16 * 48, I_WOUT = 16 * 16, I_W1 = 32 * 4, I_W2 = 4;
    constexpr int NITEMS = I_MOD + I_TBL + I_B1 + I_WIN + I_WOUT + 2 * I_W1 + 2 * I_W2;
    const int half = threadIdx.x >> 8, ht = threadIdx.x & 255;
    char* lds = lds0 + half * 73728;
    for (int it = blockIdx.x; 2 * it < NITEMS; it += gridDim.x) {
        const int item = 2 * it + half; const bool valid = item < NITEMS;
        int r = item, type = -1, a = 0;
        const float* src = nullptr; bf16_t* dst = nullptr; int K = 0, N = 0, kb = 0, nb = 0;
        if (valid) {
            if (r < I_MOD) { type = 0; a = r; }
            else if ((r -= I_MOD) < I_TBL) { type = 3; a = r; }
            else if ((r -= I_TBL) < I_B1) { type = 1; a = r; }
            else if ((r -= I_B1) < I_WIN) { type = 2; src = p.w_in; dst = WinT; K = 1024; N = NPROJ; kb = r / 48; nb = r % 48; }
            else if ((r -= I_WIN) < I_WOUT) { type = 2; src = p.w_out; dst = WoutT; K = 1024; N = 1024; kb = r / 16; nb = r % 16; }
            else if ((r -= I_WOUT) < I_W1) { type = 2; src = p.w_cmp_k1; dst = W1T; K = 2048; N = 256; kb = r / 4; nb = r % 4; }
            else if ((r -= I_W1) < I_W1) { type = 2; src = p.w_cmp_v1; dst = W1T + 256 * 2048; K = 2048; N = 256; kb = r / 4; nb = r % 4; }
            else if ((r -= I_W1) < I_W2) { type = 2; src = p.w_cmp_k2; dst = W2T; K = 256; N = 64; kb = r; nb = 0; }
            else { r -= I_W2; type = 2; src = p.w_cmp_v2; dst = W2T + 64 * 256; K = 256; N = 64; kb = r; nb = 0; }
        }
        if (type == 0) p0_mod_a(p, lds, ht); else if (type == 3) p0_tbl(p, a, ht, (float*)(p.ws + WS_TBL));
        __syncthreads();
        if (type == 0) p0_mod_b(p, a, lds, ht); else if (type == 1) p0_b1_a(p, a, lds, ht); else if (type == 2) p0_tr_a(src, N, kb, nb, lds, ht);
        __syncthreads();
        if (type == 0) p0_mod_c(p, a, lds, ht, mod); else if (type == 1) p0_b1_b(a, lds, ht, bias1); else if (type == 2) p0_tr_b(dst, K, kb, nb, lds, ht);
        __syncthreads();
    }
}

constexpr int L1_AB = 0, L1_WG = 8192, L1_WGS = 2064  , L1_WGROWS = 25  , L1_SS = L1_WG + L1_WGROWS * L1_WGS,
              L1_ACCS = 36  , L1_ACCB = 2 * 128 * L1_ACCS * 4, L1_ACC = L1_SS + 2 * 1024, L1_VB = L1_ACC + 2 * L1_ACCB, L1_END = L1_VB + 128;
static_assert(L1_END <= 147456 && L1_SS % 16 == 0 && L1_ACC % 16 == 0, "P1 LDS map");
DI void phase1(const Params& p, char* lds) {
    bf16_t* H = (bf16_t*)(p.ws + WS_H); float* GB = (float*)(p.ws + WS_GB); const float* mod = (const float*)(p.ws + WS_MOD);
    float* AB = (float*)(lds + L1_AB); float* VB = (float*)(lds + L1_VB);
    for (int rt = blockIdx.x; rt < M / 256; rt += gridDim.x) {
        int tid_ = threadIdx.x; asm volatile("" : "+v"(tid_));
        const int tid = tid_, lane = tid & 63, w = tid >> 6, tok = lane & 15, kq = lane >> 4;
        const int b = rt >> 4;
        const float* shift = mod + b * 3072; const float* scale = shift + 1024;
        __syncthreads();
        for (int k = tid; k < 1024; k += NTHREADS) { AB[k] = p.norm_gain[k] * (1.f + scale[k]); AB[1024 + k] = shift[k]; }
        __syncthreads();
        { const int c = tid & 31, kc = tid >> 5; float av = 0.f;
#pragma unroll 8
          for (int it = 0; it < 64; ++it) { const int k = kc + 16 * it; const float wr = c < 24 ? p.w_in[(size_t)k * NPROJ + 3072 + c] : 0.f;
              av += AB[1024 + k] * wr;
              if (c < L1_WGROWS) *(bf16_t*)(lds + L1_WG + c * L1_WGS + k * 2) = (bf16_t)(pk2(wr * AB[k], 0.f) & 0xffffu); }
          ((float*)(lds + L1_ACC))[kc * 32 + c] = av; }
        __syncthreads();
        if (tid < 32) { float a = 0.f; for (int kc = 0; kc < 16; ++kc) a += ((const float*)(lds + L1_ACC))[kc * 32 + tid]; VB[tid] = a + (tid < 24 ? p.b_gate[tid] : 0.f); }
        __syncthreads();
        const float* xb = p.x + ((size_t)rt * 256 + tok) * 1024 + 128 * w + 8 * kq;
        const char* wgA = lds + L1_WG + tok * L1_WGS + (128 * w + 8 * kq) * 2;
        const char* wgB = lds + L1_WG + (tok < 8 ? 16 + tok : 24) * L1_WGS + (128 * w + 8 * kq) * 2;
        f32x4 xsa[2][4][2], xsb[2][4][2];
#pragma unroll
        for (int r = 0; r < 2; ++r)
#pragma unroll
            for (int s = 0; s < 4; ++s) { xsa[r][s][0] = *(const f32x4*)(xb + r * 16 * 1024 + 32 * s); xsa[r][s][1] = *(const f32x4*)(xb + r * 16 * 1024 + 32 * s + 4); }
        auto step = [&](f32x4 (&xv)[2][4][2], f32x4 (&xl)[2][4][2], const int g) {
            if (g + 1 < 8) { const float* xg = xb + (size_t)(g + 1) * 32 * 1024;
#pragma unroll
                for (int r = 0; r < 2; ++r)
#pragma unroll
                    for (int s = 0; s < 4; ++s) { xl[r][s][0] = *(const f32x4*)(xg + r * 16 * 1024 + 32 * s); xl[r][s][1] = *(const f32x4*)(xg + r * 16 * 1024 + 32 * s + 4); } }
            float* SS = (float*)(lds + L1_SS + (g & 1) * 1024); float* ACC = (float*)(lds + L1_ACC + (g & 1) * L1_ACCB);
            float ss[2] = {0.f, 0.f}; f32x4 a0[2], a1[2];
#pragma unroll
            for (int r = 0; r < 2; ++r) { a0[r] = (f32x4){0.f, 0.f, 0.f, 0.f}; a1[r] = (f32x4){0.f, 0.f, 0.f, 0.f}; }
#pragma unroll
            for (int s = 0; s < 4; ++s) {
                const bf16x8 wf0 = *(const bf16x8*)(wgA + 64 * s), wf1 = *(const bf16x8*)(wgB + 64 * s);
#pragma unroll
                for (int r = 0; r < 2; ++r) {
                    const f32x4 u = xv[r][s][0], v = xv[r][s][1];
                    ss[r] += (u.x * u.x + u.y * u.y) + (u.z * u.z + u.w * u.w) + (v.x * v.x + v.y * v.y) + (v.z * v.z + v.w * v.w);
                    u32x4 pb; pb.x = pk2(u.x, u.y); pb.y = pk2(u.z, u.w); pb.z = pk2(v.x, v.y); pb.w = pk2(v.z, v.w);
                    const bf16x8 xf = __builtin_bit_cast(bf16x8, pb);
                    a0[r] = mfma16(wf0, xf, a0[r]); a1[r] = mfma16(wf1, xf, a1[r]);
                }
            }
#pragma unroll
            for (int r = 0; r < 2; ++r) {
                float t = ss[r]; t += __shfl_xor(t, 16); t += __shfl_xor(t, 32);
                if (kq == 0) SS[r * 128 + w * 16 + tok] = t;
                float* ar = ACC + (r * 128 + w * 16 + tok) * L1_ACCS + 4 * kq;
                *(f32x4*)ar = a0[r]; *(f32x4*)(ar + 16) = a1[r];
            }
            __syncthreads();
            float rstd[2];
#pragma unroll
            for (int r = 0; r < 2; ++r) { float t = 0.f;
#pragma unroll
                for (int ww = 0; ww < 8; ++ww) t += SS[r * 128 + ww * 16 + tok];
                rstd[r] = rsq(t * (1.f / 1024.f) + EPS); }
            bf16_t* hrow = H + ((size_t)rt * 256 + g * 32 + tok) * 1024 + 128 * w + 8 * kq;
#pragma unroll
            for (int s = 0; s < 4; ++s) { const int k = 128 * w + 32 * s + 8 * kq;
                const f32x4 g0 = *(const f32x4*)(AB + k), g1 = *(const f32x4*)(AB + k + 4), s0 = *(const f32x4*)(AB + 1024 + k), s1 = *(const f32x4*)(AB + 1024 + k + 4);
#pragma unroll
                for (int r = 0; r < 2; ++r) {
                    const f32x4 h0 = xv[r][s][0] * rstd[r] * g0 + s0, h1 = xv[r][s][1] * rstd[r] * g1 + s1;
                    u32x4 o; o.x = pk2(h0.x, h0.y); o.y = pk2(h0.z, h0.w); o.z = pk2(h1.x, h1.y); o.w = pk2(h1.z, h1.w);
                    *(u32x4*)(hrow + r * 16 * 1024 + 32 * s) = o; } }
            { const int t32 = tid >> 4, cp = tid & 15;
              const float* SSr = SS + (t32 >> 4) * 128 + (t32 & 15); const float* ACr = ACC + ((t32 >> 4) * 128 + (t32 & 15)) * L1_ACCS + cp;
              float t = 0.f, v0 = 0.f, v1 = 0.f;
#pragma unroll
              for (int ww = 0; ww < 8; ++ww) { t += SSr[ww * 16]; v0 += ACr[ww * 16 * L1_ACCS]; v1 += ACr[ww * 16 * L1_ACCS + 16]; }
              const float rs = rsq(t * (1.f / 1024.f) + EPS);
              float* gp = GB + ((size_t)rt * 256 + g * 32 + t32) * 24 + cp;
              gp[0] = sigm(rs * v0 + VB[cp]);
              if (cp < 8) gp[16] = sigm(rs * v1 + VB[16 + cp]); }
        };
#pragma unroll 1
        for (int g = 0; g < 8; g += 2) { step(xsa, xsb, g); step(xsb, xsa, g + 1); }
    }
}

DI void p3_pair(const Params& p, int it, char* lds, int tid) {
    const int lane = tid & 63, wv = tid >> 6, half = wv >> 2, w = wv & 3, ht = tid & 255;
    const int kv = it & 1, combo = 2 * (it >> 1) + half, ct = combo & 7, bg = combo >> 3, b = bg >> 1, g = bg & 1;
    const bf16_t* HM = (const bf16_t*)(p.ws + WS_HM);
    const int slot = (kv ? 30 : 28) + g;
    const bf16_t* Xbase = HM + ((size_t)slot * M + (size_t)b * 4096) * 64;
    const bf16_t* W1 = (const bf16_t*)(p.ws + WS_W1T) + (size_t)kv * 256 * 2048;
    const bf16_t* W2 = (const bf16_t*)(p.ws + WS_W2T) + (size_t)kv * 64 * 256;
    const float* bias1 = (const float*)(p.ws + WS_BIAS1) + kv * 256;
    const int srow = tid >> 3, sch = tid & 7;
    const int sofs = srow * 128 + ((sch ^ ((srow >> 1) & 7)) << 4);
    const int xrow = ht >> 3;
    const int xofs = xrow * 128 + ((sch ^ ((xrow >> 1) & 7)) << 4);
    int cx = ct * 32 + xrow; if (cx > 254) cx = 254;
    const bf16_t* xp = Xbase + (size_t)cx * 1024 + sch * 8;
    const bf16_t* wp = W1 + (size_t)srow * 2048 + sch * 8;
    constexpr int STG = 40960;
    u32x4 wrA[4], wrB[4], xrA, xrB;
    f32x4 acc[4][2];
#pragma unroll
    for (int i = 0; i < 4; ++i) { acc[i][0] = (f32x4){0.f, 0.f, 0.f, 0.f}; acc[i][1] = (f32x4){0.f, 0.f, 0.f, 0.f}; }
#define P3_LOAD(WR, XR, KT) do { _Pragma("unroll") for (int q = 0; q < 4; ++q) WR[q] = *(const u32x4*)(wp + (size_t)q * 64 * 2048 + (KT) * 64); XR = *(const u32x4*)(xp + (KT) * 64); } while (0)
#define P3_STORE(WR, XR, BUF) do { char* d_ = lds + (BUF) * STG; _Pragma("unroll") for (int q = 0; q < 4; ++q) *(u32x4*)(d_ + sofs + q * 8192) = WR[q]; *(u32x4*)(d_ + 32768 + half * 4096 + xofs) = XR; } while (0)
#define P3_COMPUTE(BUF) do { const char* sW = lds + (BUF) * STG; const char* sX = sW + 32768 + half * 4096; \
        _Pragma("unroll") for (int ks = 0; ks < 2; ++ks) { const int co = ((ks * 4 + fq) ^ fsw) << 4; bf16x8 wf[4], xf[2]; \
            _Pragma("unroll") for (int i = 0; i < 4; ++i) wf[i] = *(const bf16x8*)(sW + (w * 64 + i * 16) * 128 + fro + co); \
            _Pragma("unroll") for (int i = 0; i < 2; ++i) xf[i] = *(const bf16x8*)(sX + (i * 16) * 128 + fro + co); \
            _Pragma("unroll") for (int ni = 0; ni < 4; ++ni) _Pragma("unroll") for (int mi = 0; mi < 2; ++mi) acc[ni][mi] = mfma16(wf[ni], xf[mi], acc[ni][mi]); } } while (0)
    const int fro = (lane & 15) * 128, fsw = (lane >> 1) & 7, fq = lane >> 4;
    P3_LOAD(wrA, xrA, 0); P3_LOAD(wrB, xrB, 1);
    P3_STORE(wrA, xrA, 0);
    __syncthreads();
    for (int kt = 0; kt < 32; kt += 2) {
        if (kt + 2 < 32) P3_LOAD(wrA, xrA, kt + 2);
        P3_COMPUTE(0);
        P3_STORE(wrB, xrB, 1);
        __syncthreads();
        if (kt + 3 < 32) P3_LOAD(wrB, xrB, kt + 3);
        P3_COMPUTE(1);
        if (kt + 2 < 32) P3_STORE(wrA, xrA, 0);
        __syncthreads();
    }
#undef P3_LOAD
#undef P3_STORE
#undef P3_COMPUTE
    char* hb = lds + half * 40960;
    char* Hs = hb;
    float* Os = (float*)(hb + 16384);
    {
        const int dq = (lane >> 4) * 4;
#pragma unroll
        for (int ni = 0; ni < 4; ++ni) { const int n = w * 64 + ni * 16 + dq; const f32x4 bv = *(const f32x4*)(bias1 + n);
#pragma unroll
            for (int mi = 0; mi < 2; ++mi) { const int m = mi * 16 + (lane & 15); const f32x4 a = acc[ni][mi] + bv;
                u32x2 o; o.x = pk2(a.x * sigm(a.x), a.y * sigm(a.y)); o.y = pk2(a.z * sigm(a.z), a.w * sigm(a.w));
                *(u32x2*)(Hs + m * 512 + (((n >> 3) ^ (m & 15)) << 4) + ((n >> 2) & 1) * 8) = o; } }
    }
    __syncthreads();
    {
        f32x4 a2[2] = {(f32x4){0.f, 0.f, 0.f, 0.f}, (f32x4){0.f, 0.f, 0.f, 0.f}};
        const bf16_t* w2p = W2 + (size_t)(w * 16 + (lane & 15)) * 256 + fq * 8;
#pragma unroll
        for (int ks = 0; ks < 8; ++ks) {
            const bf16x8 wf = *(const bf16x8*)(w2p + ks * 32);
#pragma unroll
            for (int mi = 0; mi < 2; ++mi) { const int m = mi * 16 + (lane & 15);
                const bf16x8 xf = *(const bf16x8*)(Hs + m * 512 + (((ks * 4 + fq) ^ (m & 15)) << 4));
                a2[mi] = mfma16(wf, xf, a2[mi]); }
        }
#pragma unroll
        for (int mi = 0; mi < 2; ++mi) *(f32x4*)(Os + (mi * 16 + (lane & 15)) * 68 + w * 16 + fq * 4) = a2[mi];
    }
    __syncthreads();
    {
        const int m = ht >> 3, d0 = (ht & 7) * 8;
        f32x4 v0 = *(const f32x4*)(Os + m * 68 + d0), v1 = *(const f32x4*)(Os + m * 68 + d0 + 4);
        if (kv == 0) {
            float ss = (v0.x * v0.x + v0.y * v0.y) + (v0.z * v0.z + v0.w * v0.w) + (v1.x * v1.x + v1.y * v1.y) + (v1.z * v1.z + v1.w * v1.w);
            ss += __shfl_xor(ss, 1); ss += __shfl_xor(ss, 2); ss += __shfl_xor(ss, 4);
            const float rs = rsq(ss * (1.f / 64.f) + EPS);
            v0 = v0 * rs * *(const f32x4*)(p.k_gain_cmp + d0); v1 = v1 * rs * *(const f32x4*)(p.k_gain_cmp + d0 + 4);
        }
        u32x4 o; o.x = pk2(v0.x, v0.y); o.y = pk2(v0.z, v0.w); o.z = pk2(v1.x, v1.y); o.w = pk2(v1.z, v1.w);
        *(u32x4*)((bf16_t*)(p.ws + (kv ? WS_VCMP : WS_KCMP)) + ((size_t)bg * 256 + ct * 32 + m) * 64 + d0) = o;
    }
    __syncthreads();
}
DI void phase3(const Params& p, char* lds) {
    for (int it = blockIdx.x; it < 256; it += gridDim.x) p3_pair(p, it, lds, threadIdx.x);
}

constexpr int L4_WSCR = 65536;
constexpr int L4_TBL0 = L4_WSCR + 8 * 8448;
constexpr int L4_TBL1 = L4_TBL0 + 7424;
constexpr int L4_SC = L4_TBL1 + 7424;
constexpr int L4_UNIT = L4_SC + 64;
static_assert(L4_UNIT + 16 <= LDS_MISC, "P4 LDS map");
struct WB { int hi_min, hi_max, lo_min, lo_max; };

template <int OFF> DI s16x4 tr_read(unsigned a) { s16x4 r; asm volatile("ds_read_b64_tr_b16 %0, %1 offset:%2" : "=&v"(r) : "v"(a), "i"(OFF) : "memory"); return r; }
#define TR_WAIT() do { asm volatile("s_waitcnt lgkmcnt(0)" ::: "memory"); __builtin_amdgcn_sched_barrier(0); } while (0)
#define PK8(L, H) (bf16x8){L[0], L[1], L[2], L[3], H[0], H[1], H[2], H[3]}
struct LaneC { int kA, vA0, vA1, Xc, h4; };
DI void pack_p(const f32x16& s, float& lsum, bf16x8 (&pf)[2]) {
    float e[16];
#pragma unroll
    for (int r = 0; r < 16; ++r) e[r] = ex2(s[r]);
    float t0 = (e[0] + e[1]) + (e[2] + e[3]), t1 = (e[4] + e[5]) + (e[6] + e[7]), t2 = (e[8] + e[9]) + (e[10] + e[11]), t3 = (e[12] + e[13]) + (e[14] + e[15]);
    lsum += (t0 + t1) + (t2 + t3);
#pragma unroll
    for (int s2 = 0; s2 < 2; ++s2) { u32x4 pp; pp.x = pk2(e[8 * s2 + 0], e[8 * s2 + 1]); pp.y = pk2(e[8 * s2 + 2], e[8 * s2 + 3]);
        pp.z = pk2(e[8 * s2 + 4], e[8 * s2 + 5]); pp.w = pk2(e[8 * s2 + 6], e[8 * s2 + 7]); pf[s2] = __builtin_bit_cast(bf16x8, pp); }
}
DI void subtile2_pv(const char* lds, int stoff  , int k0, const LaneC& lc, const bf16x8 (&qa)[4], const bf16x8 (&qb)[4],
                    f32x16 (&OA)[2], f32x16 (&OB)[2], float& lA, float& lB,
                    const f32x16& cin  , float tadd  , bool use_tbl, int tboffA, int tboffB,
                    bool need_hi, int hi_t, bool need_lo, int lo_t) {
    f32x16 sa, sb;
    bf16x8 kf[4];
#pragma unroll
    for (int ks = 0; ks < 4; ++ks) kf[ks] = *(const bf16x8*)(lds + stoff + (lc.kA ^ (ks << 5)));
    if (use_tbl) {
#pragma unroll
        for (int i = 0; i < 16; ++i) { sa[i] = 0.f; sb[i] = 0.f; }
    } else { sa = cin; sb = cin; }
    __builtin_amdgcn_s_setprio(1);
#pragma unroll
    for (int ks = 0; ks < 4; ++ks) { sa = mfma32(kf[ks], qa[ks], sa); sb = mfma32(kf[ks], qb[ks], sb); }
    __builtin_amdgcn_s_setprio(0);
    if (use_tbl) {
        const int X = lc.Xc + k0; const int to = (X & 1) * 928 + (X & ~1) * 4; const char* tpa = lds + tboffA + to; const char* tpb = lds + tboffB + to;
#pragma unroll
        for (int q = 0; q < 4; ++q) { const f32x2 t0 = *(const f32x2*)(tpa + 32 * q), t1 = *(const f32x2*)(tpa + 32 * q + 8);
            sa[4 * q] += t0.x + tadd; sa[4 * q + 1] += t0.y + tadd; sa[4 * q + 2] += t1.x + tadd; sa[4 * q + 3] += t1.y + tadd;
            const f32x2 u0 = *(const f32x2*)(tpb + 32 * q), u1 = *(const f32x2*)(tpb + 32 * q + 8);
            sb[4 * q] += u0.x + tadd; sb[4 * q + 1] += u0.y + tadd; sb[4 * q + 2] += u1.x + tadd; sb[4 * q + 3] += u1.y + tadd; }
    }
    if (need_hi) { const int H = hi_t - k0 - lc.h4;
#pragma unroll
        for (int r = 0; r < 16; ++r) { const bool ok = (r & 3) + 8 * (r >> 2) <= H; sa[r] = ok ? sa[r] : -INFINITY; sb[r] = ok ? sb[r] : -INFINITY; } }
    if (need_lo) { const int L = lo_t - k0 - lc.h4;
#pragma unroll
        for (int r = 0; r < 16; ++r) { const bool ok = (r & 3) + 8 * (r >> 2) >= L; sa[r] = ok ? sa[r] : -INFINITY; sb[r] = ok ? sb[r] : -INFINITY; } }
    const unsigned vb = (unsigned)(size_t)(LAS const char*)lds + (unsigned)(stoff + 8192);
    const unsigned va0 = vb + (unsigned)lc.vA0, va1 = vb + (unsigned)lc.vA1;
    const s16x4 a0 = tr_read<0>(va0), a1 = tr_read<1024>(va0), a2 = tr_read<2048>(va0), a3 = tr_read<3072>(va0);
    const s16x4 b0 = tr_read<0>(va1), b1 = tr_read<1024>(va1), b2 = tr_read<2048>(va1), b3 = tr_read<3072>(va1);
    bf16x8 pa[2], pb[2];
    pack_p(sa, lA, pa);
    TR_WAIT();
    __builtin_amdgcn_s_setprio(1);
    OA[0] = mfma32(PK8(a0, a1), pa[0], OA[0]); OA[1] = mfma32(PK8(b0, b1), pa[0], OA[1]);
    OA[0] = mfma32(PK8(a2, a3), pa[1], OA[0]); OA[1] = mfma32(PK8(b2, b3), pa[1], OA[1]);
    __builtin_amdgcn_s_setprio(0);
    __builtin_amdgcn_sched_barrier(0);
    pack_p(sb, lB, pb);
    __builtin_amdgcn_sched_barrier(0);
    __builtin_amdgcn_s_setprio(1);
    OB[0] = mfma32(PK8(a0, a1), pb[0], OB[0]); OB[1] = mfma32(PK8(b0, b1), pb[0], OB[1]);
    OB[0] = mfma32(PK8(a2, a3), pb[1], OB[0]); OB[1] = mfma32(PK8(b2, b3), pb[1], OB[1]);
    __builtin_amdgcn_s_setprio(0);
}

DI void load_q(const bf16_t* HM, int slot, int m, int lane, bf16x8 (&qf)[4]) {
    const bf16_t* q = HM + ((size_t)slot * M + m) * 64 + (lane >> 5) * 8;
#pragma unroll
    for (int ks = 0; ks < 4; ++ks) qf[ks] = *(const bf16x8*)(q + ks * 16);
}
DI void write_y2(bf16_t* Y, const bf16_t* HM, int zslotA, int zslotB, int m, int colA, int colB, int lane, const f32x16 (&ya)[2], const f32x16 (&yb)[2]) {
    const int h = lane >> 5;
    const bf16_t* za = HM + ((size_t)zslotA * M + m) * 64 + 4 * h; const bf16_t* zb = HM + ((size_t)zslotB * M + m) * 64 + 4 * h;
    u32x2 zza[8], zzb[8];
#pragma unroll
    for (int i = 0; i < 8; ++i) { zza[i] = *(const u32x2*)(za + 8 * i); zzb[i] = *(const u32x2*)(zb + 8 * i); }
    asm volatile("" ::: "memory");
    bf16_t* ypa = Y + (size_t)m * 1024 + colA + 4 * h; bf16_t* ypb = Y + (size_t)m * 1024 + colB + 4 * h;
#pragma unroll
    for (int i = 0; i < 8; ++i) { const int db = i >> 2, rg = i & 3;
        u32x2 o; o.x = pk2(ya[db][4 * rg + 0] * bflo(zza[i].x), ya[db][4 * rg + 1] * bfhi(zza[i].x));
        o.y = pk2(ya[db][4 * rg + 2] * bflo(zza[i].y), ya[db][4 * rg + 3] * bfhi(zza[i].y));
        *(u32x2*)(ypa + 8 * i) = o;
        u32x2 q; q.x = pk2(yb[db][4 * rg + 0] * bflo(zzb[i].x), yb[db][4 * rg + 1] * bfhi(zzb[i].x));
        q.y = pk2(yb[db][4 * rg + 2] * bflo(zzb[i].y), yb[db][4 * rg + 3] * bfhi(zzb[i].y));
        *(u32x2*)(ypb + 8 * i) = q; }
}
DI float table_far(const float* tbl, int r) { return tbl[r * 464 + 63]; }
DI f32x16 cmp_qk(const char* lds, int st, int lane, const bf16x8 (&qf)[4]) {
    f32x16 s;
#pragma unroll
    for (int i = 0; i < 16; ++i) s[i] = 0.f;
    const int row = st * 32 + (lane & 31), h = lane >> 5; const char* kp = lds + row * 128; const int sw = (row >> 1) & 7;
#pragma unroll
    for (int ks = 0; ks < 4; ++ks) { const bf16x8 kf = *(const bf16x8*)(kp + (((2 * ks + h) ^ sw) << 4)); s = mfma32(kf, qf[ks], s); }
    return s;
}

DI void unit(const Params& p, bool isB, int bg, int qb, char* lds) {
    int tid_ = threadIdx.x; asm volatile("" : "+v"(tid_));
    const int tid = tid_, lane = tid & 63, w = __builtin_amdgcn_readfirstlane(tid >> 6), b = bg >> 1, g = bg & 1, h = lane >> 5;
    const bf16_t* HM = (const bf16_t*)(p.ws + WS_HM); bf16_t* Y = (bf16_t*)(p.ws + WS_Y); const float* GB = (const float*)(p.ws + WS_GB);
    float* tbl0 = (float*)(lds + L4_TBL0); float* tbl1 = (float*)(lds + L4_TBL1); float* sc = (float*)(lds + L4_SC);
    float* wsc = (float*)(lds + L4_WSCR + w * 8448) + lane;
    const int t0 = isB ? qb * 256 : qb * 128, tq0 = t0 + 32 * (isB ? w : (w & 3)), tq = tq0 + (lane & 31), m = b * 4096 + tq;
    const int thi = (t0 + (isB ? 255 : 127)) >> 6;
    const bf16_t* Kc = (const bf16_t*)(p.ws + WS_KCMP) + (size_t)bg * 256 * 64;
    const bf16_t* Vc = (const bf16_t*)(p.ws + WS_VCMP) + (size_t)bg * 256 * 64;
    const int hic_t = (tq - 31) >> 4;
    const int ctmax = ((t0 + 224) >> 4) >> 6;
    const float* TG = (const float*)(p.ws + WS_TBL);
    const float ccmp = TG[3 * 8 * 464 + 24];
    unsigned mask_even = 0xffffffffu, mask_odd = 0xffffffffu;
    {
        const int k0_ = isB ? 1 : 0;
        if (tid < 464) { *(f32x4*)(tbl0 + 4 * tid) = *(const f32x4*)(TG + (k0_ * 8 + 4 * g) * 464 + 4 * tid);
            if (isB) *(f32x4*)(tbl1 + 4 * tid) = *(const f32x4*)(TG + (2 * 8 + 4 * g) * 464 + 4 * tid); }
        if (tid < 4) sc[tid] = TG[3 * 8 * 464 + k0_ * 8 + 4 * g + tid];
    }
    if (isB) {
        const int nst = ((tq0 >> 4) >> 5) + 1;
        for (int i = tid; i < (ctmax + 1) * 512; i += NTHREADS) { const int row = i >> 3, ch = i & 7;
            *(u32x4*)(lds + row * 128 + ((ch ^ ((row >> 1) & 7)) << 4)) = *(const u32x4*)(Kc + (size_t)i * 8); }
        for (int i = 0; i < 33; ++i) wsc[i * 64] = 0.f;
        __syncthreads();
        {
            const int hic_min = (tq0 - 31) >> 4;
            f32x16 cinc;
#pragma unroll
            for (int i = 0; i < 16; ++i) cinc[i] = ccmp;
#pragma unroll 1
            for (int r = 0; r < 4; ++r) {
                bf16x8 qf[4]; load_q(HM, 20 + 4 * g + r, m, lane, qf);
                float lsum = 0.f;
                float E[33];
#pragma unroll
                for (int i = 0; i < 33; ++i) E[i] = 0.f;
#pragma unroll
                for (int st = 0; st < 8; ++st) {
                    if (st < nst) {
                        f32x16 s = cinc;
                        { const int row = st * 32 + (lane & 31); const char* kp = lds + row * 128; const int sw = (row >> 1) & 7;
#pragma unroll
                          for (int ks = 0; ks < 4; ++ks) { const bf16x8 kf = *(const bf16x8*)(kp + (((2 * ks + h) ^ sw) << 4)); s = mfma32(kf, qf[ks], s); } }
                        if (st * 32 + 31 > hic_min) { const int H = hic_t - st * 32 - 4 * h;
#pragma unroll
                            for (int i = 0; i < 16; ++i) s[i] = ((i & 3) + 8 * (i >> 2) <= H) ? s[i] : -INFINITY; }
#pragma unroll
                        for (int q = 0; q < 4; ++q) {
                            const float e0 = ex2(s[4 * q]), e1 = ex2(s[4 * q + 1]), e2 = ex2(s[4 * q + 2]), e3 = ex2(s[4 * q + 3]);
                            lsum += (e0 + e1) + (e2 + e3);
                            const float half = 0.5f * e3;
                            const float recv = __shfl_xor(half, 32);
                            E[st * 4 + q] += (e0 + e1) + (e2 + half) + (h ? recv : 0.f);
                            E[st * 4 + q + 1] += (h ? 0.f : recv);
                        }
                    }
                }
                const float l = lsum + __shfl_xor(lsum, 32);
                const float inv = l > 0.f ? 1.f / l : 0.f;
#pragma unroll
                for (int i = 0; i < 33; ++i) wsc[i * 64] += E[i] * inv;
            }
        }
        const int cur = tq0 >> 6;
        if (cur >= 16) {
            unsigned* keyL = (unsigned*)wsc;
#pragma unroll 4
            for (int i = 0; i < 32; ++i) { const int j = 2 * i + h; const bool ok = (j >= 1) && (j <= cur - 2);
                const unsigned bits = __builtin_bit_cast(unsigned, wsc[i * 64]);
                keyL[i * 64] = ok ? ((bits & 0xffffffc0u) + 64u + (unsigned)(63 - j)) : 0u; }
            mask_even = 1u; mask_odd = 0u;
            if (cur & 1) { mask_odd |= 1u << (cur >> 1); mask_even |= 1u << ((cur - 1) >> 1); }
            else { mask_even |= 1u << (cur >> 1); mask_odd |= 1u << ((cur - 1) >> 1); }
#pragma unroll 1
            for (int it = 0; it < 13; ++it) {
                unsigned mx = 0u;
#pragma unroll 8
                for (int i = 0; i < 32; ++i) { const unsigned k = keyL[i * 64]; mx = mx > k ? mx : k; }
                const unsigned mo = (unsigned)__shfl_xor((int)mx, 32); mx = mx > mo ? mx : mo;
                const int j = 63 - (int)(mx & 63u);
                if ((j & 1) == h) keyL[(j >> 1) * 64] = 0u;
                if (j & 1) mask_odd |= 1u << (j >> 1); else mask_even |= 1u << (j >> 1);
            }
        }
    }
    __syncthreads();
    const int nbr = isB ? 3 : 1;
    int lo0, hi0, lo1 = 0, hi1 = 0, lo2 = 0, hi2 = 0;
    const bf16_t *Kb0, *Vb0, *Kb1 = nullptr, *Vb1 = nullptr, *Kb2 = nullptr, *Vb2 = nullptr;
    if (!isB) { lo0 = (t0 - 128) < 0 ? 0 : ((t0 - 128) >> 6); hi0 = thi;
        Kb0 = HM + ((size_t)(8 + g) * M + (size_t)b * 4096) * 64; Vb0 = HM + ((size_t)(10 + g) * M + (size_t)b * 4096) * 64; }
    else { lo0 = 0; hi0 = ctmax; lo1 = 0; hi1 = thi; lo2 = (t0 - 512) < 0 ? 0 : ((t0 - 512) >> 6); hi2 = thi;
        Kb0 = Kc; Vb0 = Vc;
        Kb1 = HM + ((size_t)(32 + g) * M + (size_t)b * 4096) * 64; Vb1 = HM + ((size_t)(34 + g) * M + (size_t)b * 4096) * 64;
        Kb2 = HM + ((size_t)(36 + g) * M + (size_t)b * 4096) * 64; Vb2 = HM + ((size_t)(38 + g) * M + (size_t)b * 4096) * 64; }
    int l_it = 0, l_br = 0, l_tile = lo0, k_issued = 0, kidx = 0;
    const int n_it = isB ? 2 * nbr : 1;
    const int drow = 8 * w + (lane >> 3), dpc = lane & 7;
    const int koff = drow * 64 + ((dpc ^ ((drow >> 1) & 7)) << 3);
    const int voff = drow * 64 + ((dpc ^ (((drow >> 1) & 1) << 2)) << 3);
    LaneC lc;
    { const int kr = lane & 31, i16 = lane & 15, q4 = i16 >> 2, p4 = i16 & 3, g16 = (lane >> 4) & 1, vsw = ((q4 >> 1) & 1) << 3, cb = 4 * g16 + p4;
      lc.kA = kr * 128 + ((h ^ ((kr >> 1) & 7)) << 4);
      lc.vA0 = (4 * h + q4) * 128 + ((cb ^ vsw) << 3); lc.vA1 = (4 * h + q4) * 128 + (((8 + cb) ^ vsw) << 3);
      lc.Xc = 191 - tq + 4 * h; lc.h4 = 4 * h; }
#define ISSUE_INTERVAL() do { if (l_it < n_it) { \
        const bf16_t* kb_ = l_br == 0 ? Kb0 : (l_br == 1 ? Kb1 : Kb2); const bf16_t* vb_ = l_br == 0 ? Vb0 : (l_br == 1 ? Vb1 : Vb2); \
        const int lhi_ = l_br == 0 ? hi0 : (l_br == 1 ? hi1 : hi2); \
        LAS unsigned* dst_ = (LAS unsigned*)(lds + (k_issued & 1) * 32768 + w * 1024); \
        __builtin_amdgcn_global_load_lds((const unsigned*)(kb_ + (size_t)l_tile * 4096 + koff), dst_, 16, 0, 0); \
        __builtin_amdgcn_global_load_lds((const unsigned*)(vb_ + (size_t)l_tile * 4096 + voff), dst_ + 2048, 16, 0, 0); \
        if (l_tile < lhi_) { \
            __builtin_amdgcn_global_load_lds((const unsigned*)(kb_ + (size_t)(l_tile + 1) * 4096 + koff), dst_ + 4096, 16, 0, 0); \
            __builtin_amdgcn_global_load_lds((const unsigned*)(vb_ + (size_t)(l_tile + 1) * 4096 + voff), dst_ + 6144, 16, 0, 0); } \
        l_tile += 2; \
        if (l_tile > lhi_) { ++l_it; l_br = (l_br + 1 == nbr) ? 0 : l_br + 1; l_tile = l_br == 0 ? lo0 : (l_br == 1 ? lo1 : lo2); } } \
        ++k_issued; } while (0)
    ISSUE_INTERVAL();
    bf16x8 qfa[4], qfb[4];
    unsigned* wpk = (unsigned*)wsc;
#pragma unroll 1
    for (int it = 0; it < n_it; ++it) {
        const int hp = isB ? it / 3 : (w >> 2), br = isB ? it - 3 * hp : 0, rA = 2 * hp, rB = 2 * hp + 1;
        const int mode = isB ? br + 1 : 0;
        if (br == 0) { load_q(HM, (isB ? 20 : 0) + 4 * g + rA, m, lane, qfa); load_q(HM, (isB ? 20 : 0) + 4 * g + rB, m, lane, qfb); }
        const int tlo = __builtin_amdgcn_readfirstlane(br == 0 ? lo0 : (br == 1 ? lo1 : lo2)), th = __builtin_amdgcn_readfirstlane(br == 0 ? hi0 : (br == 1 ? hi1 : hi2));
        int hi_t = tq, lo_t = 0; bool bias = true, sel = false, scaled = true;
        int tboffA = L4_TBL0 + rA * 1856, tboffB = L4_TBL0 + rB * 1856; WB wb; wb.hi_min = tq0; wb.hi_max = tq0 + 31; wb.lo_min = 0; wb.lo_max = 0;
        float gateA = 1.f, gateB = 1.f, ccom = 0.f, fA = 1.f, fB = 1.f;
        if (mode == 0) { lo_t = tq - 127; wb.lo_min = tq0 - 127; wb.lo_max = tq0 + 31 - 127; }
        else if (mode == 1) { hi_t = hic_t; bias = false; wb.hi_min = (tq0 - 31) >> 4; wb.hi_max = tq0 >> 4; ccom = ccmp; }
        else if (mode == 2) { sel = true; scaled = false; ccom = TG[3 * 8 * 464 + 25 + 1]; fA = ex2(table_far(tbl0, rA) - ccom); fB = ex2(table_far(tbl0, rB) - ccom); }
        else { tboffA = L4_TBL1 + rA * 1856; tboffB = L4_TBL1 + rB * 1856; scaled = false; ccom = TG[3 * 8 * 464 + 25 + 2];
            fA = ex2(table_far(tbl1, rA) - ccom); fB = ex2(table_far(tbl1, rB) - ccom);
            lo_t = tq - 511; wb.lo_min = tq0 - 511; wb.lo_max = tq0 + 31 - 511; }
        if (isB) { gateA = GB[(size_t)m * 24 + (4 * g + rA) * 3 + br]; gateB = GB[(size_t)m * 24 + (4 * g + rB) * 3 + br]; }
        f32x16 OA[2], OB[2], cin;
#pragma unroll
        for (int i = 0; i < 16; ++i) { OA[0][i] = 0.f; OA[1][i] = 0.f; OB[0][i] = 0.f; OB[1][i] = 0.f; cin[i] = ccom; }
        float lA = 0.f, lB = 0.f;
#pragma unroll 1
        for (int tile0 = tlo; tile0 <= th; tile0 += 2) {
            asm volatile("s_waitcnt vmcnt(0)" ::: "memory");
            __builtin_amdgcn_s_barrier();
            asm volatile("" ::: "memory");
            ISSUE_INTERVAL();
            const int sbase = (kidx & 1) * 32768;
            ++kidx;
#pragma unroll 1
            for (int tt = 0; tt < 2; ++tt) {
                const int tile = tile0 + tt;
                if (tile > th) break;
                const int stoff = sbase + tt * 16384;
                float selterm = 0.f; bool any = true;
                if (sel) { const unsigned mk = (tile & 1) ? mask_odd : mask_even; const bool bit = (mk >> (tile >> 1)) & 1u;
                    selterm = bit ? 0.f : -INFINITY; any = __ballot(bit) != 0ull;
                    if (any) { const float cv = bit ? ccom : -INFINITY;
#pragma unroll
                        for (int i = 0; i < 16; ++i) cin[i] = cv; } }
                if (any) {
#pragma unroll
                    for (int sub = 0; sub < 2; ++sub) {
                        const int k0 = tile * 64 + sub * 32;
                        if (k0 > wb.hi_max || k0 + 31 < wb.lo_min) continue;
                        const bool need_hi = k0 + 31 > wb.hi_min, need_lo = k0 < wb.lo_max;
                        const bool use_tbl = bias && (tq0 - (k0 + 31) < 128);
                        if (use_tbl && !scaled) {
                            scaled = true;
#pragma unroll
                            for (int i = 0; i < 16; ++i) { OA[0][i] *= fA; OA[1][i] *= fA; OB[0][i] *= fB; OB[1][i] *= fB; }
                            lA *= fA; lB *= fB; }
                        subtile2_pv(lds, stoff + sub * 4096, k0, lc, qfa, qfb, OA, OB, lA, lB, cin, selterm, use_tbl, tboffA, tboffB, need_hi, hi_t, need_lo, lo_t);
                    }
                }
            }
        }
        if (!scaled) { lA *= fA; lB *= fB;
#pragma unroll
            for (int i = 0; i < 16; ++i) { OA[0][i] *= fA; OA[1][i] *= fA; OB[0][i] *= fB; OB[1][i] *= fB; } }
        float la = lA + __shfl_xor(lA, 32), lb = lB + __shfl_xor(lB, 32);
        if (mode == 0) { la += ex2((p.sinks[4 * g + rA] - sc[rA]) * LOG2E); lb += ex2((p.sinks[4 * g + rB] - sc[rB]) * LOG2E); }
        const float sa_ = (la > 0.f ? 1.f / la : 0.f) * gateA, sb_ = (lb > 0.f ? 1.f / lb : 0.f) * gateB;
#pragma unroll
        for (int i = 0; i < 16; ++i) { OA[0][i] *= sa_; OA[1][i] *= sa_; OB[0][i] *= sb_; OB[1][i] *= sb_; }
        if (br != 0) {
#pragma unroll
            for (int i = 0; i < 8; ++i) { const unsigned u0 = wpk[i * 64], u1 = wpk[(8 + i) * 64], v0 = wpk[(16 + i) * 64], v1 = wpk[(24 + i) * 64];
                OA[0][2 * i] += bflo(u0); OA[0][2 * i + 1] += bfhi(u0); OA[1][2 * i] += bflo(u1); OA[1][2 * i + 1] += bfhi(u1);
                OB[0][2 * i] += bflo(v0); OB[0][2 * i + 1] += bfhi(v0); OB[1][2 * i] += bflo(v1); OB[1][2 * i + 1] += bfhi(v1); }
        }
        if (br == nbr - 1) {
            write_y2(Y, HM, (isB ? 40 : 12) + 4 * g + rA, (isB ? 40 : 12) + 4 * g + rB, m, (isB ? 512 : 0) + (4 * g + rA) * 64, (isB ? 512 : 0) + (4 * g + rB) * 64, lane, OA, OB);
        } else {
#pragma unroll
            for (int i = 0; i < 8; ++i) { wpk[i * 64] = pk2(OA[0][2 * i], OA[0][2 * i + 1]); wpk[(8 + i) * 64] = pk2(OA[1][2 * i], OA[1][2 * i + 1]);
                wpk[(16 + i) * 64] = pk2(OB[0][2 * i], OB[0][2 * i + 1]); wpk[(24 + i) * 64] = pk2(OB[1][2 * i], OB[1][2 * i + 1]); }
        }
    }
#undef ISSUE_INTERVAL
    asm volatile("s_waitcnt vmcnt(0)" ::: "memory");
    __syncthreads();
}

DI void phase4(const Params& p, char* lds) {
    unsigned* ctr = (unsigned*)(p.ws + WS_CTL);
    volatile int* su = (volatile int*)(lds + L4_UNIT);
    for (;;) {
        if (threadIdx.x == 0) *su = (int)atomicAdd(ctr, 1u);
        __syncthreads();
        const int u = __builtin_amdgcn_readfirstlane(*su);
        __syncthreads();
        if (u >= 1536) break;
        const bool isB = u < 512; const int uu = isB ? u : u - 512;
        unit(p, isB, uu & 31, (isB ? 15 : 31) - (uu >> 5), lds);
    }
}

__global__ void __launch_bounds__(NTHREADS, 2) fwd_kernel(Params p) {
    extern __shared__ __attribute__((aligned(16))) char lds[];
    const int lo = p.ph_lo, hi = p.ph_hi;
    volatile LAS unsigned* misc = (volatile LAS unsigned*)(LAS char*)(lds + LDS_MISC);
    if (threadIdx.x < 16) misc[threadIdx.x] = 0u;
    __syncthreads();
    XcdBarrier bar = xcd_barrier_post((unsigned*)(p.ws + WS_CTL) + 1024, misc);
#define IN(k) (lo <= (k) && (k) < hi)
#define SEAM(k) do { if (IN((k) + 1)) xcd_barrier(bar); } while (0)
    if (IN(0)) { phase0(p, lds); SEAM(0); }
    if (IN(1)) { phase1(p, lds); SEAM(1); }
    if (IN(2)) {
        pg8::Gemm gm{(const bf16_t*)(p.ws + WS_H), (const bf16_t*)(p.ws + WS_WINT), M, NPADW, 1024};
        pg8::StaticOrder S; S.init(M, NPADW, (int)gridDim.x, (int)blockIdx.x);
        EpiIn E{(bf16_t*)(p.ws + WS_HM), (float*)(p.ws + WS_GB), p.q_gain_a, p.k_gain_a, p.q_gain_b, p.k_gain_sel, p.k_gain_win, p.b_gate};
        pg8::gemm_phase<EpiIn, pg8::StaticOrder, GEMM_ALIGN, GEMM_SP2>((LAS unsigned char*)lds, gm, S, E);
        SEAM(2);
    }
    if (IN(3)) { phase3(p, lds); SEAM(3); }
    if (IN(4)) { phase4(p, lds); SEAM(4); }
    if (IN(5)) {
        pg8::Gemm gm{(const bf16_t*)(p.ws + WS_Y), (const bf16_t*)(p.ws + WS_WOUTT), M, 1024, 1024};
        pg8::StaticOrder S; S.init(M, 1024, (int)gridDim.x, (int)blockIdx.x);
        EpiOut E{p.x, (const float*)(p.ws + WS_MOD), p.out};
        pg8::gemm_phase<EpiOut, pg8::StaticOrder, GEMM_ALIGN, GEMM_SP2>((LAS unsigned char*)lds, gm, S, E);
    }
#undef IN
#undef SEAM
}

extern "C" void kernel_launch(void* const* d_in, const int* in_sizes, int n_in, void* d_out, int out_size, void* d_ws, size_t ws_size, hipStream_t stream) {
    static int grid = 0;
    if (grid == 0) {
        if (n_in != 22 || out_size != M * DM || ws_size < WS_END) { fprintf(stderr, "kernel_launch: unexpected shapes (n_in %d out %d ws %zu need %zu)\n", n_in, out_size, ws_size, (size_t)WS_END); grid = -1; return; }
        int dev = 0, cus = 0, per_cu = 0;
        (void)hipGetDevice(&dev); (void)hipDeviceGetAttribute(&cus, hipDeviceAttributeMultiprocessorCount, dev);
        (void)hipFuncSetAttribute((const void*)fwd_kernel, hipFuncAttributeMaxDynamicSharedMemorySize, LDS_BYTES);
        (void)hipOccupancyMaxActiveBlocksPerMultiprocessor(&per_cu, (const void*)fwd_kernel, NTHREADS, LDS_BYTES);
        if (per_cu < 1) { fprintf(stderr, "kernel_launch: occupancy query says %d blocks/CU\n", per_cu); grid = -1; return; }
        grid = cus;
        fprintf(stderr, "kernel_launch: cus %d per_cu %d grid %d\n", cus, per_cu, grid);
    }
    if (grid < 0) return;
    (void)hipMemsetAsync((char*)d_ws + WS_CTL, 0, CTL_BYTES, stream);
    Params p{};
    const float** pin = (const float**)&p;
    for (int i = 0; i < 22; ++i) pin[i] = (const float*)d_in[i];
    p.out = (float*)d_out; p.ws = (unsigned char*)d_ws;
#if N_LAUNCHES == 1
    p.ph_lo = 0; p.ph_hi = 6;
    void* args[] = {&p};
    hipError_t e = hipLaunchCooperativeKernel((const void*)fwd_kernel, dim3(grid), dim3(NTHREADS), args, LDS_BYTES, stream);
    if (e != hipSuccess) fprintf(stderr, "cooperative launch failed: %s (grid %d)\n", hipGetErrorString(e), grid);
#else
    for (int ph = 0; ph < 6; ++ph) { p.ph_lo = ph; p.ph_hi = ph + 1; hipLaunchKernelGGL(fwd_kernel, dim3(grid), dim3(NTHREADS), LDS_BYTES, stream, p); }
#endif
}
```

```cpp
#include <hip/hip_runtime.h>
#include <cstdio>
#include <cstdint>

#ifndef GEMM_ALIGN
#define GEMM_ALIGN true
#endif
#ifndef GEMM_SP2
#define GEMM_SP2 true
#endif
#ifndef N_LAUNCHES
#define N_LAUNCHES 1
#endif

#define DI __device__ __forceinline__
#define LAS __attribute__((address_space(3)))
typedef unsigned short bf16_t;
typedef short bf16x8 __attribute__((ext_vector_type(8)));
typedef short s16x4 __attribute__((ext_vector_type(4)));
typedef float f32x2 __attribute__((ext_vector_type(2)));
typedef float f32x4 __attribute__((ext_vector_type(4)));
typedef float f32x16 __attribute__((ext_vector_type(16)));
typedef unsigned u32x2 __attribute__((ext_vector_type(2)));
typedef unsigned u32x4 __attribute__((ext_vector_type(4)));
typedef __bf16 bf16x2v __attribute__((ext_vector_type(2)));

constexpr int NBATCH = 16, SEQ = 4096, M = NBATCH * SEQ, DM = 1024, NPROJ = 3096, NPADW = 3072;
constexpr float EPS = 1e-6f, LOG2E = 1.4426950408889634f;
constexpr size_t MiB = 1u << 20;
constexpr size_t WS_CTL = 0;
constexpr size_t CTL_BYTES = 32768;
constexpr size_t WS_MOD = 1 * MiB;
constexpr size_t WS_BIAS1 = WS_MOD + 256 * 1024;
constexpr size_t WS_MODP = 24 * MiB;
constexpr size_t WS_TBL = WS_MOD + 512 * 1024;
constexpr size_t WS_W2T = 2 * MiB;
constexpr size_t WS_W1T = 3 * MiB;
constexpr size_t WS_WOUTT = 5 * MiB;
constexpr size_t WS_WINT = 7 * MiB;
constexpr size_t WS_KCMP = 14 * MiB;
constexpr size_t WS_VCMP = 15 * MiB;
constexpr size_t WS_GB = 16 * MiB;
constexpr size_t WS_H = 32 * MiB;
constexpr size_t WS_Y = 160 * MiB;
constexpr size_t WS_HM = 288 * MiB;
constexpr size_t WS_END = WS_HM + (size_t)48 * M * 64 * 2;
constexpr int LDS_BYTES = 148992;
constexpr int LDS_MISC = 148480;
constexpr int NTHREADS = 512;

struct Params {
    const float *x, *c, *w_ada, *b_ada, *norm_gain, *w_in, *b_gate, *q_gain_a, *k_gain_a, *sinks, *q_gain_b,
        *k_gain_cmp, *k_gain_sel, *k_gain_win, *cmp_pos_k, *cmp_pos_v, *w_cmp_k1, *w_cmp_k2, *w_cmp_v1, *w_cmp_v2, *w_out, *rel_bias;
    float* out; unsigned char* ws; int ph_lo, ph_hi;
};

DI unsigned pk2(float lo, float hi) { f32x2 v = {lo, hi}; bf16x2v b = __builtin_convertvector(v, bf16x2v); return __builtin_bit_cast(unsigned, b); }
DI float bflo(unsigned u) { return __builtin_bit_cast(float, u << 16); }
DI float bfhi(unsigned u) { return __builtin_bit_cast(float, u & 0xffff0000u); }
DI float ex2(float x) { return __builtin_amdgcn_exp2f(x); }
DI float rsq(float x) { return __builtin_amdgcn_rsqf(x); }
DI float sigm(float x) { return __builtin_amdgcn_rcpf(1.f + __builtin_amdgcn_exp2f(x * -LOG2E)); }
DI float wave_sum(float v) {
#pragma unroll
    for (int o = 1; o < 64; o <<= 1) v += __shfl_xor(v, o);
    return v;
}
DI f32x4 mfma16(bf16x8 a, bf16x8 b, f32x4 c) { return __builtin_amdgcn_mfma_f32_16x16x32_bf16(a, b, c, 0, 0, 0); }
DI f32x16 mfma32(bf16x8 a, bf16x8 b, f32x16 c) { return __builtin_amdgcn_mfma_f32_32x32x16_bf16(a, b, c, 0, 0, 0); }
DI int t5_bucket(int n) {
    if (n < 16) return n < 0 ? 0 : n;
    int b = 16;
    b += (n >= 19); b += (n >= 21); b += (n >= 24); b += (n >= 27); b += (n >= 31); b += (n >= 35); b += (n >= 40); b += (n >= 46);
    b += (n >= 52); b += (n >= 59); b += (n >= 67); b += (n >= 77); b += (n >= 87); b += (n >= 99); b += (n >= 113);
    return b;
}

#define XB_TMO      128
#define XB_XCNT(j)  (256  + 64 * (j))
#define XB_XSUB(j)  (1280 + 64 * (j))
#define XB_XGEN(j)  (2304 + 64 * (j))
#define XB_TOP      3328
#define XB_TOPGEN   3392
#define XCD_BAR_WORDS 3456
#define XB_SPIN_CAP (1u << 18)
DI unsigned xb_ld(unsigned* p)              { return __hip_atomic_load(p, __ATOMIC_RELAXED, __HIP_MEMORY_SCOPE_AGENT); }
DI unsigned xb_add(unsigned* p, unsigned v) { return __hip_atomic_fetch_add(p, v, __ATOMIC_RELAXED, __HIP_MEMORY_SCOPE_AGENT); }
DI unsigned xb_xcc_id() { return (unsigned)__builtin_amdgcn_s_getreg((3 << 11) | 20) & 0xFu; }
#define XB_SPIN(cond, bar) do { unsigned _sp = 0; while (cond) { __builtin_amdgcn_s_sleep(1); \
    if ((++_sp & 255u) == 0u) { if (xb_ld(&(bar)[XB_TMO])) break; if (_sp > XB_SPIN_CAP) { atomicAdd(&(bar)[XB_TMO], 1u); break; } } } } while (0)
struct XcdBarrier { unsigned* bar; unsigned x; volatile LAS unsigned* st; };
DI XcdBarrier xcd_barrier_post(unsigned* bar, volatile LAS unsigned* st) {
    XcdBarrier b; b.bar = bar; b.x = xb_xcc_id(); b.st = st;
    if (threadIdx.x == 0) (void)xb_add(&bar[XB_XCNT(b.x)], 1u);
    return b;
}
DI void xcd_barrier_complete(unsigned* bar, unsigned x, unsigned& nloc, unsigned& nx) {
    const unsigned G = gridDim.x * gridDim.y * gridDim.z;
    unsigned sum, cnt, mine, sp = 0u;
    for (;;) {
        sum = 0u; cnt = 0u; mine = 0u;
#pragma unroll
        for (unsigned j = 0; j < 16; ++j) { const unsigned c = xb_ld(&bar[XB_XCNT(j)]); sum += c; cnt += (c > 0u) ? 1u : 0u; mine = (j == x) ? c : mine; }
        if (sum == G) break;
        __builtin_amdgcn_s_sleep(1);
        if ((++sp & 255u) == 0u) { if (xb_ld(&bar[XB_TMO])) break; if (sp > XB_SPIN_CAP) { atomicAdd(&bar[XB_TMO], 1u); break; } }
    }
    nloc = mine > 0u ? mine : 1u; nx = cnt > 0u ? cnt : 1u;
}
DI void xcd_barrier(const XcdBarrier& b) {
    asm volatile("s_waitcnt vmcnt(0)" ::: "memory");
    __syncthreads();
    if (threadIdx.x == 0) {
        unsigned* bar = b.bar;
        __builtin_amdgcn_s_waitcnt(0);
        unsigned nloc = b.st[0], nx = b.st[1];
        if (nloc == 0u) { xcd_barrier_complete(bar, b.x, nloc, nx); b.st[0] = nloc; b.st[1] = nx; }
        const unsigned old = xb_add(&bar[XB_XSUB(b.x)], 1u);
        const unsigned gen = old / nloc;
        if (old + 1u == (gen + 1u) * nloc) {
            __builtin_amdgcn_fence(__ATOMIC_RELEASE, "agent");
            asm volatile("s_waitcnt vmcnt(0)" ::: "memory");
            const unsigned og = xb_add(&bar[XB_TOP], 1u);
            const unsigned tg = og / nx;
            if (og + 1u == (tg + 1u) * nx) xb_add(&bar[XB_TOPGEN], 1u);
            else XB_SPIN(xb_ld(&bar[XB_TOPGEN]) == tg, bar);
            __builtin_amdgcn_fence(__ATOMIC_ACQUIRE, "agent");
            xb_add(&bar[XB_XGEN(b.x)], 1u);
            asm volatile("s_waitcnt vmcnt(0)" ::: "memory");
        } else {
            XB_SPIN(xb_ld(&bar[XB_XGEN(b.x)]) == gen, bar);
            __builtin_amdgcn_fence(__ATOMIC_ACQUIRE, "agent");
            asm volatile("s_waitcnt vmcnt(0)" ::: "memory");
        }
    }
    __syncthreads();
}

namespace pg8 {
constexpr int BM = 256, BK = 64, HALF = 128, HTB = HALF * BK * 2, STAGE_BYTES = 8 * HTB, NXCD = 8, WGM = 8;
__host__ __device__ __forceinline__ int lds_byte(int r, int c) { const int st = (r >> 4) * 2 + (c >> 5), rr = r & 15, cc = c & 31, ob = rr * 64 + cc * 2; return st * 1024 + (ob ^ (((ob >> 9) & 1) << 5)); }
__host__ __device__ __forceinline__ void stage_rc(int b, int& R, int& C) { const int st = b / 1024, sb = b % 1024, swz = sb ^ (((sb >> 9) & 1) << 5); R = (st >> 1) * 16 + swz / 64; C = (st & 1) * 32 + (swz % 64) / 2; }
__host__ __device__ __forceinline__ int perm32(int rho) { const int n = rho >> 4, i = rho & 15; return 8 * (i >> 2) + 4 * n + (i & 3); }
struct Unit { int pm, pn; };
struct Gemm { const bf16_t* A; const bf16_t* Bt; int M, N, K; };
struct StaticOrder {
    int nM, nN, nwg, G, c;
    __host__ __device__ void init(int M_, int N_, int G_, int c_) { nM = M_ / BM; nN = N_ / BM; nwg = nM * nN; G = G_; c = c_; }
    __host__ __device__ bool next(int i, Unit& u) const {
        const long L = (long)i * G + c; if (L >= nwg) return false;
        int wgid = (int)L; { const int q = nwg / NXCD, r = nwg % NXCD, xcd = wgid % NXCD, off = wgid / NXCD; wgid = (xcd < r ? xcd * (q + 1) : r * (q + 1) + (xcd - r) * q) + off; }
        const int nig = WGM * nN, gid = wgid / nig, fm = gid * WGM, gsz = (nM - fm) < WGM ? (nM - fm) : WGM;
        u.pm = fm + ((wgid % nig) % gsz); u.pn = (wgid % nig) / gsz; return true;
    }
};
template <class Epi, class Sched, bool ALIGN_EPI, bool SP2>
__device__ __forceinline__ void gemm_phase(LAS unsigned char* lds, const Gemm g, const Sched& S, const Epi& E) {
    const int tid = threadIdx.x, wid = __builtin_amdgcn_readfirstlane(tid >> 6), lane = tid & 63, wr = wid >> 2, wc = wid & 3, fr = lane & 15, fq = lane >> 4;
    const int K = g.K, nt = K / BK;
    unsigned voffA[2], voffB[2];
#pragma unroll
    for (int i = 0; i < 2; ++i) { int R, C; stage_rc(tid * 16 + i * 8192, R, C); const int Rb = Epi::brow(R);
        voffA[i] = (unsigned)(R * K + C) * 2u; voffB[i] = (unsigned)(Rb * K + C) * 2u; }
    const size_t kstep = (size_t)(BK * 2);
    const size_t hstep = (size_t)HALF * K * 2;
    const size_t hstepB = (size_t)Epi::BHALF * K * 2;
    const size_t tstep = 2 * hstep;
    const unsigned ldsw = (unsigned)wid * 1024u;
    const int aoff = lds_byte(wr * 64 + fr, fq * 8), boff = lds_byte(wc * 32 + fr, fq * 8);
#define PG8_SA(b, h) (((b) * 2 + (h)) * HTB)
#define PG8_SB(b, h) ((4 + (b) * 2 + (h)) * HTB)
#define PG8_STAGE(bufoff, gbase, voff) do { _Pragma("unroll") for (int _i = 0; _i < 2; ++_i) \
        __builtin_amdgcn_global_load_lds((const unsigned*)((const char*)(gbase) + (voff)[_i]), (LAS unsigned*)(lds + (bufoff) + ldsw + _i * 8192), 16, 0, 0); } while (0)
#define PG8_LDA(dst, b, h) do { _Pragma("unroll") for (int m = 0; m < 4; ++m) _Pragma("unroll") for (int k = 0; k < 2; ++k) dst[m][k] = *(const LAS bf16x8*)(lds + PG8_SA(b, h) + aoff + m * 2048 + k * 1024); } while (0)
#define PG8_LDB(dst, b, h) do { _Pragma("unroll") for (int n = 0; n < 2; ++n) _Pragma("unroll") for (int k = 0; k < 2; ++k) dst[n][k] = *(const LAS bf16x8*)(lds + PG8_SB(b, h) + boff + n * 2048 + k * 1024); } while (0)
#define PG8_MMA(ai, bj, At, Bt) do { __builtin_amdgcn_s_setprio(1); _Pragma("unroll") for (int m = 0; m < 4; ++m) _Pragma("unroll") for (int n = 0; n < 2; ++n) _Pragma("unroll") for (int k = 0; k < 2; ++k) \
        acc[ai][bj][m][n] = __builtin_amdgcn_mfma_f32_16x16x32_bf16(Bt[n][k], At[m][k], acc[ai][bj][m][n], 0, 0, 0); __builtin_amdgcn_s_setprio(0); } while (0)
#define PG8_WAIT_V(n) asm volatile("s_waitcnt vmcnt(" #n ")" ::: "memory")
#define PG8_WAIT_L(n) asm volatile("s_waitcnt lgkmcnt(" #n ")" ::: "memory")
#define PG8_BAR __builtin_amdgcn_s_barrier()
#define PG8_SCHED __builtin_amdgcn_sched_barrier(0)
    Unit cur, nxt; int ui = 0;
    if (!S.next(0, cur)) return;
    f32x4 acc[2][2][4][2];
#pragma unroll
    for (int a = 0; a < 2; ++a)
#pragma unroll
        for (int b = 0; b < 2; ++b)
#pragma unroll
            for (int m = 0; m < 4; ++m)
#pragma unroll
                for (int n = 0; n < 2; ++n) acc[a][b][m][n] = (f32x4){0.f, 0.f, 0.f, 0.f};
    bf16x8 At[4][2], B0[2][2], B1[2][2];
    const char* cA = (const char*)g.A + (size_t)cur.pm * tstep; const char* cB = (const char*)g.Bt + (size_t)cur.pn * tstep;
    if constexpr (SP2) {
        PG8_STAGE(PG8_SB(0, 0), cB, voffB); PG8_STAGE(PG8_SB(0, 1), cB + hstepB, voffB); PG8_STAGE(PG8_SA(0, 0), cA, voffA); PG8_STAGE(PG8_SA(0, 1), cA + hstep, voffA);
        if (wr == 1) PG8_BAR;
        PG8_WAIT_V(2); PG8_BAR;
        PG8_STAGE(PG8_SB(1, 0), cB + kstep, voffB); PG8_STAGE(PG8_SA(1, 0), cA + kstep, voffA); PG8_STAGE(PG8_SB(1, 1), cB + hstepB + kstep, voffB);
        PG8_WAIT_V(6); PG8_BAR;
    } else {
        PG8_STAGE(PG8_SB(0, 0), cB, voffB); PG8_STAGE(PG8_SA(0, 0), cA, voffA); PG8_STAGE(PG8_SB(0, 1), cB + hstepB, voffB); PG8_STAGE(PG8_SA(0, 1), cA + hstep, voffA);
        if (wr == 1) PG8_BAR;
        PG8_WAIT_V(4); PG8_BAR;
        PG8_STAGE(PG8_SB(1, 0), cB + kstep, voffB); PG8_STAGE(PG8_SA(1, 0), cA + kstep, voffA); PG8_STAGE(PG8_SB(1, 1), cB + hstepB + kstep, voffB);
        PG8_WAIT_V(6); PG8_BAR;
    }
    for (;;) {
        const bool has_next = S.next(ui + 1, nxt);
        const char* nA = has_next ? (const char*)g.A + (size_t)nxt.pm * tstep : cA; const char* nB = has_next ? (const char*)g.Bt + (size_t)nxt.pn * tstep : cB;
        for (int t = 0; t < nt; t += 2) {
            const bool last = (t == nt - 2);
            const char* a1 = cA + (size_t)(t + 1) * kstep;
            const char* a2 = last ? nA : cA + (size_t)(t + 2) * kstep; const char* b2 = last ? nB : cB + (size_t)(t + 2) * kstep;
            const char* a3 = a2 + kstep; const char* b3 = b2 + kstep;
            if constexpr (SP2) {
            PG8_LDB(B0, 0, 0); PG8_LDB(B1, 0, 1); PG8_SCHED; PG8_LDA(At, 0, 0); PG8_STAGE(PG8_SA(1, 1), a1 + hstep, voffA);
            PG8_WAIT_V(8); PG8_WAIT_L(0); PG8_BAR; PG8_MMA(0, 0, At, B0); PG8_MMA(0, 1, At, B1); PG8_BAR; PG8_SCHED;
            PG8_LDA(At, 0, 1); PG8_STAGE(PG8_SB(0, 0), b2, voffB); PG8_STAGE(PG8_SB(0, 1), b2 + hstepB, voffB); PG8_STAGE(PG8_SA(0, 0), a2, voffA);
            PG8_WAIT_V(8); PG8_WAIT_L(0); PG8_BAR; PG8_MMA(1, 0, At, B0); PG8_MMA(1, 1, At, B1); PG8_BAR; PG8_SCHED;
            PG8_LDB(B0, 1, 0); PG8_LDB(B1, 1, 1); PG8_SCHED; PG8_LDA(At, 1, 0); PG8_STAGE(PG8_SA(0, 1), a2 + hstep, voffA);
            PG8_WAIT_V(8); PG8_WAIT_L(0); PG8_BAR; PG8_MMA(0, 0, At, B0); PG8_MMA(0, 1, At, B1); PG8_BAR; PG8_SCHED;
            PG8_LDA(At, 1, 1); PG8_STAGE(PG8_SB(1, 0), b3, voffB); PG8_STAGE(PG8_SB(1, 1), b3 + hstepB, voffB); PG8_STAGE(PG8_SA(1, 0), a3, voffA);
            PG8_WAIT_V(8); PG8_WAIT_L(0); PG8_BAR; PG8_MMA(1, 0, At, B0); PG8_MMA(1, 1, At, B1); PG8_BAR; PG8_SCHED;
            } else {
            PG8_LDB(B0, 0, 0); PG8_SCHED; PG8_LDA(At, 0, 0); PG8_STAGE(PG8_SA(1, 1), a1 + hstep, voffA);
            PG8_WAIT_L(8); PG8_BAR; PG8_WAIT_L(0); PG8_MMA(0, 0, At, B0); PG8_BAR; PG8_SCHED;
            PG8_LDB(B1, 0, 1); PG8_STAGE(PG8_SB(0, 0), b2, voffB);
            PG8_BAR; PG8_WAIT_L(0); PG8_MMA(0, 1, At, B1); PG8_BAR;
            PG8_LDA(At, 0, 1); PG8_STAGE(PG8_SA(0, 0), a2, voffA);
            PG8_BAR; PG8_WAIT_L(0); PG8_MMA(1, 0, At, B0); PG8_BAR; PG8_SCHED;
            PG8_STAGE(PG8_SB(0, 1), b2 + hstepB, voffB);
            PG8_WAIT_V(6); PG8_BAR; PG8_MMA(1, 1, At, B1); PG8_BAR;
            PG8_LDB(B0, 1, 0); PG8_SCHED; PG8_LDA(At, 1, 0); PG8_STAGE(PG8_SA(0, 1), a2 + hstep, voffA);
            PG8_WAIT_L(8); PG8_BAR; PG8_WAIT_L(0); PG8_MMA(0, 0, At, B0); PG8_BAR; PG8_SCHED;
            PG8_LDB(B1, 1, 1); PG8_STAGE(PG8_SB(1, 0), b3, voffB);
            PG8_BAR; PG8_WAIT_L(0); PG8_MMA(0, 1, At, B1); PG8_BAR;
            PG8_LDA(At, 1, 1); PG8_STAGE(PG8_SA(1, 0), a3, voffA);
            PG8_BAR; PG8_WAIT_L(0); PG8_MMA(1, 0, At, B0); PG8_BAR; PG8_SCHED;
            PG8_STAGE(PG8_SB(1, 1), b3 + hstepB, voffB);
            PG8_WAIT_V(6); PG8_BAR; PG8_MMA(1, 1, At, B1); PG8_BAR;
            }
        }
        if constexpr (ALIGN_EPI) { if (wr == 0) PG8_BAR; }
        E(acc, cur, wr, wc, fr, fq);
        if (!has_next) break;
#pragma unroll
        for (int a = 0; a < 2; ++a)
#pragma unroll
            for (int b = 0; b < 2; ++b)
#pragma unroll
                for (int m = 0; m < 4; ++m)
#pragma unroll
                    for (int n = 0; n < 2; ++n) acc[a][b][m][n] = (f32x4){0.f, 0.f, 0.f, 0.f};
        cur = nxt; cA = nA; cB = nB; ++ui;
        if constexpr (ALIGN_EPI) { if (wr == 1) PG8_BAR; }
    }
    PG8_WAIT_V(0);
    if constexpr (!ALIGN_EPI) { if (wr == 0) PG8_BAR; }
    PG8_BAR;
#undef PG8_SA
#undef PG8_SB
#undef PG8_STAGE
#undef PG8_LDA
#undef PG8_LDB
#undef PG8_MMA
#undef PG8_WAIT_V
#undef PG8_WAIT_L
#undef PG8_BAR
#undef PG8_SCHED
}
}

struct EpiIn {
    static constexpr int BHALF = 32;
    __host__ __device__ static int brow(int R) { return 64 * (R >> 5) + pg8::perm32(R & 31); }
    bf16_t* HM; float* GB; const float *q_gain_a, *k_gain_a, *q_gain_b, *k_gain_sel, *k_gain_win, *b_gate;
    DI void operator()(const f32x4 (&acc)[2][2][4][2], const pg8::Unit& u, int wr, int wc, int fr, int fq) const {
        const int row0 = u.pm * 256 + wr * 64 + fr;
        const int slot = u.pn * 4 + wc;
        bf16_t* base = HM + ((size_t)slot * M + row0) * 64 + 8 * fq;
        const float* gain = nullptr; float extra = 1.f; int kind = 0;
        if (slot < 8) { gain = q_gain_a; extra = 0.125f * LOG2E; kind = 1; }
        else if (slot < 10) { gain = k_gain_a; kind = 1; }
        else if (slot < 12) kind = 0;
        else if (slot < 20) kind = 2;
        else if (slot < 28) { gain = q_gain_b; extra = 0.125f * LOG2E; kind = 1; }
        else if (slot < 32) kind = 0;
        else if (slot < 34) { gain = k_gain_sel; kind = 1; }
        else if (slot < 36) kind = 0;
        else if (slot < 38) { gain = k_gain_win; kind = 1; }
        else if (slot < 40) kind = 0;
        else kind = 2;
        if (kind == 1) {
            f32x4 gv[2][2];
#pragma unroll
            for (int bj = 0; bj < 2; ++bj)
#pragma unroll
                for (int n = 0; n < 2; ++n) gv[bj][n] = *(const f32x4*)(gain + 32 * bj + 8 * fq + 4 * n);
#pragma unroll
            for (int ai = 0; ai < 2; ++ai)
#pragma unroll
                for (int m = 0; m < 4; ++m) {
                    float ss = 0.f;
#pragma unroll
                    for (int bj = 0; bj < 2; ++bj)
#pragma unroll
                        for (int n = 0; n < 2; ++n) { const f32x4 a = acc[ai][bj][m][n]; ss += (a.x * a.x + a.y * a.y) + (a.z * a.z + a.w * a.w); }
                    ss += __shfl_xor(ss, 16); ss += __shfl_xor(ss, 32);
                    const float rs = rsq(ss * (1.f / 64.f) + EPS) * extra;
#pragma unroll
                    for (int bj = 0; bj < 2; ++bj) { const f32x4 v0 = acc[ai][bj][m][0] * rs * gv[bj][0], v1 = acc[ai][bj][m][1] * rs * gv[bj][1];
                        u32x4 w; w.x = pk2(v0.x, v0.y); w.y = pk2(v0.z, v0.w); w.z = pk2(v1.x, v1.y); w.w = pk2(v1.z, v1.w);
                        *(u32x4*)(base + (size_t)(ai * 128 + m * 16) * 64 + 32 * bj) = w; }
                }
        } else {
#pragma unroll
            for (int ai = 0; ai < 2; ++ai)
#pragma unroll
                for (int m = 0; m < 4; ++m)
#pragma unroll
                    for (int bj = 0; bj < 2; ++bj) { f32x4 v0 = acc[ai][bj][m][0], v1 = acc[ai][bj][m][1];
                        if (kind == 2) { v0.x *= sigm(v0.x); v0.y *= sigm(v0.y); v0.z *= sigm(v0.z); v0.w *= sigm(v0.w);
                                         v1.x *= sigm(v1.x); v1.y *= sigm(v1.y); v1.z *= sigm(v1.z); v1.w *= sigm(v1.w); }
                        u32x4 w; w.x = pk2(v0.x, v0.y); w.y = pk2(v0.z, v0.w); w.z = pk2(v1.x, v1.y); w.w = pk2(v1.z, v1.w);
                        *(u32x4*)(base + (size_t)(ai * 128 + m * 16) * 64 + 32 * bj) = w; }
        }
    }
};
struct EpiOut {
    static constexpr int BHALF = 128;
    __host__ __device__ static int brow(int R) { return R; }
    const float* x; const float* mod; float* out;
    DI void operator()(const f32x4 (&acc)[2][2][4][2], const pg8::Unit& u, int wr, int wc, int fr, int fq) const {
        const int row0 = u.pm * 256 + wr * 64 + fr, col0 = u.pn * 256 + wc * 32 + 4 * fq;
        const float* gate = mod + (u.pm >> 4) * 3072 + 2048 + col0;
        f32x4 gv[2][2];
#pragma unroll
        for (int bj = 0; bj < 2; ++bj)
#pragma unroll
            for (int n = 0; n < 2; ++n) gv[bj][n] = *(const f32x4*)(gate + bj * 128 + n * 16);
        f32x4 xa[2][2][2], xb[2][2][2];
#define EO_OFF(q, mm) ((size_t)(row0 + ((q) >> 1) * 128 + (((q) & 1) * 2 + (mm)) * 16) * 1024 + col0)
#define EO_LOAD(XV, q) do { _Pragma("unroll") for (int mm = 0; mm < 2; ++mm) _Pragma("unroll") for (int bj = 0; bj < 2; ++bj) _Pragma("unroll") for (int n = 0; n < 2; ++n) \
            XV[mm][bj][n] = *(const f32x4*)(x + EO_OFF(q, mm) + bj * 128 + n * 16); } while (0)
#define EO_STORE(XV, q) do { _Pragma("unroll") for (int mm = 0; mm < 2; ++mm) _Pragma("unroll") for (int bj = 0; bj < 2; ++bj) _Pragma("unroll") for (int n = 0; n < 2; ++n) \
            *(f32x4*)(out + EO_OFF(q, mm) + bj * 128 + n * 16) = XV[mm][bj][n] + gv[bj][n] * acc[(q) >> 1][bj][((q) & 1) * 2 + mm][n]; } while (0)
        __builtin_amdgcn_s_waitcnt(0x0F70);
        EO_LOAD(xa, 0);
        __builtin_amdgcn_sched_barrier(0);
        EO_LOAD(xb, 1);
        __builtin_amdgcn_sched_barrier(0);
        EO_STORE(xa, 0);
        __builtin_amdgcn_sched_barrier(0);
        EO_LOAD(xa, 2);
        __builtin_amdgcn_sched_barrier(0);
        EO_STORE(xb, 1);
        __builtin_amdgcn_sched_barrier(0);
        EO_LOAD(xb, 3);
        __builtin_amdgcn_sched_barrier(0);
        EO_STORE(xa, 2);
        EO_STORE(xb, 3);
        asm volatile("" ::: "memory");
#undef EO_OFF
#undef EO_LOAD
#undef EO_STORE
    }
};

DI void p0_mod_a(const Params& p, int item, char* lds, int ht) {
    float* sc = (float*)lds;
    const int k0 = (item / 48) * 256;
    float cv[16];
#pragma unroll
    for (int j = 0; j < 16; ++j) { const int i = ht + 256 * j; cv[j] = p.c[(i >> 8) * 1024 + k0 + (i & 255)]; }
#pragma unroll
    for (int j = 0; j < 16; ++j) { const int i = ht + 256 * j; sc[(i & 255) * 16 + (i >> 8)] = cv[j] * sigm(cv[j]); }
}
DI void p0_mod_b(const Params& p, int item, char* lds, int ht) {
    const int cgi = ht & 15, kg = ht >> 4, lane = ht & 63, n0 = (item % 48) * 64, k0 = (item / 48) * 256;
    const float* sc = (const float*)lds; float* red = (float*)(lds + 16384);
    f32x4 acc[16];
#pragma unroll
    for (int b = 0; b < 16; ++b) acc[b] = (f32x4){0.f, 0.f, 0.f, 0.f};
    f32x4 wa[8], wb[8];
#pragma unroll
    for (int kk = 0; kk < 8; ++kk) wa[kk] = *(const f32x4*)(p.w_ada + (size_t)(k0 + kg * 16 + kk) * 3072 + n0 + 4 * cgi);
#pragma unroll
    for (int kk = 0; kk < 8; ++kk) wb[kk] = *(const f32x4*)(p.w_ada + (size_t)(k0 + kg * 16 + 8 + kk) * 3072 + n0 + 4 * cgi);
#pragma unroll 1
    for (int c = 0; c < 2; ++c) {
#pragma unroll
        for (int kk = 0; kk < 8; ++kk) {
            const f32x4* s4 = (const f32x4*)(sc + (kg * 16 + c * 8 + kk) * 16);
            const f32x4 w = wa[kk];
#pragma unroll
            for (int q = 0; q < 4; ++q) { const f32x4 sv = s4[q]; acc[4 * q] += w * sv.x; acc[4 * q + 1] += w * sv.y; acc[4 * q + 2] += w * sv.z; acc[4 * q + 3] += w * sv.w; }
        }
#pragma unroll
        for (int kk = 0; kk < 8; ++kk) wa[kk] = wb[kk];
    }
    const int r = (ht >> 6) * 2 + ((lane >> 4) & 1);
#pragma unroll
    for (int b = 0; b < 16; ++b) { f32x4 a = acc[b];
        a.x += __shfl_xor(a.x, 32); a.y += __shfl_xor(a.y, 32); a.z += __shfl_xor(a.z, 32); a.w += __shfl_xor(a.w, 32);
        if (lane < 32) *(f32x4*)(red + (r * 16 + b) * 64 + 4 * cgi) = a; }
}
DI void p0_mod_c(const Params& p, int item, char* lds, int ht) {
    const int cgi = ht & 15, b = ht >> 4, n0 = (item % 48) * 64, kq = item / 48; const float* red = (const float*)(lds + 16384);
    f32x4 sacc = {0.f, 0.f, 0.f, 0.f};
#pragma unroll
    for (int r = 0; r < 8; ++r) sacc += *(const f32x4*)(red + (r * 16 + b) * 64 + 4 * cgi);
    *(f32x4*)((float*)(p.ws + WS_MODP) + ((size_t)kq * 16 + b) * 3072 + n0 + 4 * cgi) = sacc;
}
DI void p0_tr_a(const float* src, int N, int kb, int nb, char* lds, int ht) {
    float* t = (float*)lds; const int k0 = kb * 64, n0 = nb * 64;
#pragma unroll 4
    for (int i = 0; i < 16; ++i) { const int r = i * 4 + (ht >> 6), cc = ht & 63;
        t[r * 65 + cc] = (n0 + cc < N) ? src[(size_t)(k0 + r) * N + n0 + cc] : 0.f; }
}
DI void p0_tr_b(bf16_t* dst, int K, int kb, int nb, char* lds, int ht) {
    const float* t = (const float*)lds; const int k0 = kb * 64, n0 = nb * 64, n = ht >> 2, kc = (ht & 3) * 16;
    u32x4 o0, o1;
    o0.x = pk2(t[(kc + 0) * 65 + n], t[(kc + 1) * 65 + n]); o0.y = pk2(t[(kc + 2) * 65 + n], t[(kc + 3) * 65 + n]);
    o0.z = pk2(t[(kc + 4) * 65 + n], t[(kc + 5) * 65 + n]); o0.w = pk2(t[(kc + 6) * 65 + n], t[(kc + 7) * 65 + n]);
    o1.x = pk2(t[(kc + 8) * 65 + n], t[(kc + 9) * 65 + n]); o1.y = pk2(t[(kc + 10) * 65 + n], t[(kc + 11) * 65 + n]);
    o1.z = pk2(t[(kc + 12) * 65 + n], t[(kc + 13) * 65 + n]); o1.w = pk2(t[(kc + 14) * 65 + n], t[(kc + 15) * 65 + n]);
    u32x4* d = (u32x4*)(dst + (size_t)(n0 + n) * K + k0 + kc); d[0] = o0; d[1] = o1;
}
DI void p0_b1_a(const Params& p, int item, char* lds, int ht) {
    const int kv = item >> 4, n0 = (item & 15) * 16, col = ht & 15, kg = ht >> 4;
    const float* pos = kv ? p.cmp_pos_v : p.cmp_pos_k; const float* w1 = kv ? p.w_cmp_v1 : p.w_cmp_k1;
    float a = 0.f;
#pragma unroll 1
    for (int c = 0; c < 4; ++c) {
        float wv[32];
#pragma unroll
        for (int kk = 0; kk < 32; ++kk) wv[kk] = w1[(size_t)(kg * 128 + c * 32 + kk) * 256 + n0 + col];
#pragma unroll
        for (int kk = 0; kk < 32; ++kk) a += pos[kg * 128 + c * 32 + kk] * wv[kk];
    }
    ((float*)lds)[kg * 16 + col] = a;
}
DI void p0_b1_b(int item, char* lds, int ht, float* bias1) {
    const float* red = (const float*)lds; const int kv = item >> 4, n0 = (item & 15) * 16;
    if (ht < 16) { float a = 0.f;
#pragma unroll
        for (int kg = 0; kg < 16; ++kg) a += red[kg * 16 + ht];
        bias1[kv * 256 + n0 + ht] = a; }
}
DI void p0_tbl(const Params& p, int kind, int ht, float* T) {
    const float* gq = kind == 0 ? p.q_gain_a : p.q_gain_b; const float* gk = kind == 0 ? p.k_gain_a : (kind == 1 ? p.k_gain_sel : p.k_gain_win);
    const int head0 = kind == 0 ? 0 : 8;
    float gm = 0.f;
    for (int d = 0; d < 64; ++d) gm = fmaxf(gm, fabsf(gq[d] * gk[d]));
    for (int idx = ht; idx < 8 * 464; idx += 256) { const int r = idx / 464, rem = idx - r * 464, cp = rem / 232, i = rem - cp * 232;
        int dist = 191 - i - cp; dist = dist < 0 ? 0 : (dist > 128 ? 128 : dist);
        float bm = 0.f;
        for (int bk = 0; bk < 32; ++bk) bm = fmaxf(bm, p.rel_bias[bk * 16 + head0 + r]);
        const float shift = 8.f * gm + bm;
        T[(kind * 8 + r) * 464 + rem] = (p.rel_bias[t5_bucket(dist) * 16 + head0 + r] - shift) * LOG2E;
        if (rem == 0) T[3 * 8 * 464 + kind * 8 + r] = shift; }
    if (ht == 0) T[3 * 8 * 464 + 25 + kind] = -8.f * gm * LOG2E;
    if (kind == 0 && ht == 0) { float gc = 0.f; for (int d = 0; d < 64; ++d) gc = fmaxf(gc, fabsf(p.q_gain_b[d] * p.k_gain_cmp[d])); T[3 * 8 * 464 + 24] = -8.f * gc * LOG2E; }
}
DI void phase0(const Params& p, char* lds0) {
    float* bias1 = (float*)(p.ws + WS_BIAS1);
    bf16_t* WinT = (bf16_t*)(p.ws + WS_WINT); bf16_t* WoutT = (bf16_t*)(p.ws + WS_WOUTT);
    bf16_t* W1T = (bf16_t*)(p.ws + WS_W1T); bf16_t* W2T = (bf16_t*)(p.ws + WS_W2T);
    constexpr int I_MOD = 192, I_TBL = 3, I_B1 = 32, I_WIN = 16 * 48, I_WOUT = 16 * 16, I_W1 = 32 * 4, I_W2 = 4;
    constexpr int NITEMS = I_MOD + I_TBL + I_B1 + I_WIN + I_WOUT + 2 * I_W1 + 2 * I_W2;
    const int half = threadIdx.x >> 8, ht = threadIdx.x & 255;
    char* lds = lds0 + half * 73728;
    for (int it = blockIdx.x; 2 * it < NITEMS; it += gridDim.x) {
        const int item = 2 * it + half; const bool valid = item < NITEMS;
        int r = item, type = -1, a = 0;
        const float* src = nullptr; bf16_t* dst = nullptr; int K = 0, N = 0, kb = 0, nb = 0;
        if (valid) {
            if (r < I_MOD) { type = 0; a = r; }
            else if ((r -= I_MOD) < I_TBL) { type = 3; a = r; }
            else if ((r -= I_TBL) < I_B1) { type = 1; a = r; }
            else if ((r -= I_B1) < I_WIN) { type = 2; src = p.w_in; dst = WinT; K = 1024; N = NPROJ; kb = r / 48; nb = r % 48; }
            else if ((r -= I_WIN) < I_WOUT) { type = 2; src = p.w_out; dst = WoutT; K = 1024; N = 1024; kb = r / 16; nb = r % 16; }
            else if ((r -= I_WOUT) < I_W1) { type = 2; src = p.w_cmp_k1; dst = W1T; K = 2048; N = 256; kb = r / 4; nb = r % 4; }
            else if ((r -= I_W1) < I_W1) { type = 2; src = p.w_cmp_v1; dst = W1T + 256 * 2048; K = 2048; N = 256; kb = r / 4; nb = r % 4; }
            else if ((r -= I_W1) < I_W2) { type = 2; src = p.w_cmp_k2; dst = W2T; K = 256; N = 64; kb = r; nb = 0; }
            else { r -= I_W2; type = 2; src = p.w_cmp_v2; dst = W2T + 64 * 256; K = 256; N = 64; kb = r; nb = 0; }
        }
        if (type == 0) p0_mod_a(p, a, lds, ht); else if (type == 3) p0_tbl(p, a, ht, (float*)(p.ws + WS_TBL));
        __syncthreads();
        if (type == 0) p0_mod_b(p, a, lds, ht); else if (type == 1) p0_b1_a(p, a, lds, ht); else if (type == 2) p0_tr_a(src, N, kb, nb, lds, ht);
        __syncthreads();
        if (type == 0) p0_mod_c(p, a, lds, ht); else if (type == 1) p0_b1_b(a, lds, ht, bias1); else if (type == 2) p0_tr_b(dst, K, kb, nb, lds, ht);
        __syncthreads();
    }
}

constexpr int L1_AB = 0, L1_WG = 8192, L1_WGS = 2064  , L1_WGROWS = 25  , L1_SS = L1_WG + L1_WGROWS * L1_WGS,
              L1_ACCS = 36  , L1_ACCB = 2 * 128 * L1_ACCS * 4, L1_ACC = L1_SS + 2 * 1024, L1_VB = L1_ACC + 2 * L1_ACCB, L1_END = L1_VB + 128;
static_assert(L1_END <= 147456 && L1_SS % 16 == 0 && L1_ACC % 16 == 0, "P1 LDS map");
DI void phase1(const Params& p, char* lds) {
    bf16_t* H = (bf16_t*)(p.ws + WS_H); float* GB = (float*)(p.ws + WS_GB); float* mod = (float*)(p.ws + WS_MOD);
    float* AB = (float*)(lds + L1_AB); float* VB = (float*)(lds + L1_VB);
    for (int rt = blockIdx.x; rt < M / 256; rt += gridDim.x) {
        int tid_ = threadIdx.x; asm volatile("" : "+v"(tid_));
        const int tid = tid_, lane = tid & 63, w = tid >> 6, tok = lane & 15, kq = lane >> 4;
        const int b = rt >> 4;
        const float* mp = (const float*)(p.ws + WS_MODP) + b * 3072;
        __syncthreads();
        for (int k = tid; k < 1024; k += NTHREADS) {
            float sh = p.b_ada[k], sl = p.b_ada[1024 + k];
#pragma unroll
            for (int q = 0; q < 4; ++q) { sh += mp[(size_t)q * 16 * 3072 + k]; sl += mp[(size_t)q * 16 * 3072 + 1024 + k]; }
            AB[k] = p.norm_gain[k] * (1.f + sl); AB[1024 + k] = sh; }
        if ((rt & 15) == 0) {
            for (int k = tid; k < 1024; k += NTHREADS) { float gt = p.b_ada[2048 + k];
#pragma unroll
                for (int q = 0; q < 4; ++q) gt += mp[(size_t)q * 16 * 3072 + 2048 + k];
                mod[b * 3072 + 2048 + k] = gt; } }
        __syncthreads();
        { const int c = tid & 31, kc = tid >> 5; float av = 0.f;
#pragma unroll 8
          for (int it = 0; it < 64; ++it) { const int k = kc + 16 * it; const float wr = c < 24 ? p.w_in[(size_t)k * NPROJ + 3072 + c] : 0.f;
              av += AB[1024 + k] * wr;
              if (c < L1_WGROWS) *(bf16_t*)(lds + L1_WG + c * L1_WGS + k * 2) = (bf16_t)(pk2(wr * AB[k], 0.f) & 0xffffu); }
          ((float*)(lds + L1_ACC))[kc * 32 + c] = av; }
        __syncthreads();
        if (tid < 32) { float a = 0.f; for (int kc = 0; kc < 16; ++kc) a += ((const float*)(lds + L1_ACC))[kc * 32 + tid]; VB[tid] = a + (tid < 24 ? p.b_gate[tid] : 0.f); }
        __syncthreads();
        const float* xb = p.x + ((size_t)rt * 256 + tok) * 1024 + 128 * w + 8 * kq;
        const char* wgA = lds + L1_WG + tok * L1_WGS + (128 * w + 8 * kq) * 2;
        const char* wgB = lds + L1_WG + (tok < 8 ? 16 + tok : 24) * L1_WGS + (128 * w + 8 * kq) * 2;
        f32x4 xsa[2][4][2], xsb[2][4][2];
#pragma unroll
        for (int r = 0; r < 2; ++r)
#pragma unroll
            for (int s = 0; s < 4; ++s) { xsa[r][s][0] = *(const f32x4*)(xb + r * 16 * 1024 + 32 * s); xsa[r][s][1] = *(const f32x4*)(xb + r * 16 * 1024 + 32 * s + 4); }
        auto step = [&](f32x4 (&xv)[2][4][2], f32x4 (&xl)[2][4][2], const int g) {
            if (g + 1 < 8) { const float* xg = xb + (size_t)(g + 1) * 32 * 1024;
#pragma unroll
                for (int r = 0; r < 2; ++r)
#pragma unroll
                    for (int s = 0; s < 4; ++s) { xl[r][s][0] = *(const f32x4*)(xg + r * 16 * 1024 + 32 * s); xl[r][s][1] = *(const f32x4*)(xg + r * 16 * 1024 + 32 * s + 4); } }
            float* SS = (float*)(lds + L1_SS + (g & 1) * 1024); float* ACC = (float*)(lds + L1_ACC + (g & 1) * L1_ACCB);
            float ss[2] = {0.f, 0.f}; f32x4 a0[2], a1[2];
#pragma unroll
            for (int r = 0; r < 2; ++r) { a0[r] = (f32x4){0.f, 0.f, 0.f, 0.f}; a1[r] = (f32x4){0.f, 0.f, 0.f, 0.f}; }
#pragma unroll
            for (int s = 0; s < 4; ++s) {
                const bf16x8 wf0 = *(const bf16x8*)(wgA + 64 * s), wf1 = *(const bf16x8*)(wgB + 64 * s);
#pragma unroll
                for (int r = 0; r < 2; ++r) {
                    const f32x4 u = xv[r][s][0], v = xv[r][s][1];
                    ss[r] += (u.x * u.x + u.y * u.y) + (u.z * u.z + u.w * u.w) + (v.x * v.x + v.y * v.y) + (v.z * v.z + v.w * v.w);
                    u32x4 pb; pb.x = pk2(u.x, u.y); pb.y = pk2(u.z, u.w); pb.z = pk2(v.x, v.y); pb.w = pk2(v.z, v.w);
                    const bf16x8 xf = __builtin_bit_cast(bf16x8, pb);
                    a0[r] = mfma16(wf0, xf, a0[r]); a1[r] = mfma16(wf1, xf, a1[r]);
                }
            }
#pragma unroll
            for (int r = 0; r < 2; ++r) {
                float t = ss[r]; t += __shfl_xor(t, 16); t += __shfl_xor(t, 32);
                if (kq == 0) SS[r * 128 + w * 16 + tok] = t;
                float* ar = ACC + (r * 128 + w * 16 + tok) * L1_ACCS + 4 * kq;
                *(f32x4*)ar = a0[r]; *(f32x4*)(ar + 16) = a1[r];
            }
            __syncthreads();
            float rstd[2];
#pragma unroll
            for (int r = 0; r < 2; ++r) { float t = 0.f;
#pragma unroll
                for (int ww = 0; ww < 8; ++ww) t += SS[r * 128 + ww * 16 + tok];
                rstd[r] = rsq(t * (1.f / 1024.f) + EPS); }
            bf16_t* hrow = H + ((size_t)rt * 256 + g * 32 + tok) * 1024 + 128 * w + 8 * kq;
#pragma unroll
            for (int s = 0; s < 4; ++s) { const int k = 128 * w + 32 * s + 8 * kq;
                const f32x4 g0 = *(const f32x4*)(AB + k), g1 = *(const f32x4*)(AB + k + 4), s0 = *(const f32x4*)(AB + 1024 + k), s1 = *(const f32x4*)(AB + 1024 + k + 4);
#pragma unroll
                for (int r = 0; r < 2; ++r) {
                    const f32x4 h0 = xv[r][s][0] * rstd[r] * g0 + s0, h1 = xv[r][s][1] * rstd[r] * g1 + s1;
                    u32x4 o; o.x = pk2(h0.x, h0.y); o.y = pk2(h0.z, h0.w); o.z = pk2(h1.x, h1.y); o.w = pk2(h1.z, h1.w);
                    *(u32x4*)(hrow + r * 16 * 1024 + 32 * s) = o; } }
            { const int t32 = tid >> 4, cp = tid & 15;
              const float* SSr = SS + (t32 >> 4) * 128 + (t32 & 15); const float* ACr = ACC + ((t32 >> 4) * 128 + (t32 & 15)) * L1_ACCS + cp;
              float t = 0.f, v0 = 0.f, v1 = 0.f;
#pragma unroll
              for (int ww = 0; ww < 8; ++ww) { t += SSr[ww * 16]; v0 += ACr[ww * 16 * L1_ACCS]; v1 += ACr[ww * 16 * L1_ACCS + 16]; }
              const float rs = rsq(t * (1.f / 1024.f) + EPS);
              float* gp = GB + ((size_t)rt * 256 + g * 32 + t32) * 24 + cp;
              gp[0] = sigm(rs * v0 + VB[cp]);
              if (cp < 8) gp[16] = sigm(rs * v1 + VB[16 + cp]); }
        };
#pragma unroll 1
        for (int g = 0; g < 8; g += 2) { step(xsa, xsb, g); step(xsb, xsa, g + 1); }
    }
}

DI void p3_pair(const Params& p, int it, char* lds, int tid) {
    const int lane = tid & 63, wv = tid >> 6, half = wv >> 2, w = wv & 3, ht = tid & 255;
    const int kv = it & 1, combo = 2 * (it >> 1) + half, ct = combo & 7, bg = combo >> 3, b = bg >> 1, g = bg & 1;
    const bf16_t* HM = (const bf16_t*)(p.ws + WS_HM);
    const int slot = (kv ? 30 : 28) + g;
    const bf16_t* Xbase = HM + ((size_t)slot * M + (size_t)b * 4096) * 64;
    const bf16_t* W1 = (const bf16_t*)(p.ws + WS_W1T) + (size_t)kv * 256 * 2048;
    const bf16_t* W2 = (const bf16_t*)(p.ws + WS_W2T) + (size_t)kv * 64 * 256;
    const float* bias1 = (const float*)(p.ws + WS_BIAS1) + kv * 256;
    const int srow = tid >> 3, sch = tid & 7;
    const int sofs = srow * 128 + ((sch ^ ((srow >> 1) & 7)) << 4);
    const int xrow = ht >> 3;
    const int xofs = xrow * 128 + ((sch ^ ((xrow >> 1) & 7)) << 4);
    int cx = ct * 32 + xrow; if (cx > 254) cx = 254;
    const bf16_t* xp = Xbase + (size_t)cx * 1024 + sch * 8;
    const bf16_t* wp = W1 + (size_t)srow * 2048 + sch * 8;
    constexpr int STG = 40960;
    u32x4 wrA[4], wrB[4], xrA, xrB;
    f32x4 acc[4][2];
#pragma unroll
    for (int i = 0; i < 4; ++i) { acc[i][0] = (f32x4){0.f, 0.f, 0.f, 0.f}; acc[i][1] = (f32x4){0.f, 0.f, 0.f, 0.f}; }
#define P3_LOAD(WR, XR, KT) do { _Pragma("unroll") for (int q = 0; q < 4; ++q) WR[q] = *(const u32x4*)(wp + (size_t)q * 64 * 2048 + (KT) * 64); XR = *(const u32x4*)(xp + (KT) * 64); } while (0)
#define P3_STORE(WR, XR, BUF) do { char* d_ = lds + (BUF) * STG; _Pragma("unroll") for (int q = 0; q < 4; ++q) *(u32x4*)(d_ + sofs + q * 8192) = WR[q]; *(u32x4*)(d_ + 32768 + half * 4096 + xofs) = XR; } while (0)
#define P3_COMPUTE(BUF) do { const char* sW = lds + (BUF) * STG; const char* sX = sW + 32768 + half * 4096; \
        _Pragma("unroll") for (int ks = 0; ks < 2; ++ks) { const int co = ((ks * 4 + fq) ^ fsw) << 4; bf16x8 wf[4], xf[2]; \
            _Pragma("unroll") for (int i = 0; i < 4; ++i) wf[i] = *(const bf16x8*)(sW + (w * 64 + i * 16) * 128 + fro + co); \
            _Pragma("unroll") for (int i = 0; i < 2; ++i) xf[i] = *(const bf16x8*)(sX + (i * 16) * 128 + fro + co); \
            _Pragma("unroll") for (int ni = 0; ni < 4; ++ni) _Pragma("unroll") for (int mi = 0; mi < 2; ++mi) acc[ni][mi] = mfma16(wf[ni], xf[mi], acc[ni][mi]); } } while (0)
    const int fro = (lane & 15) * 128, fsw = (lane >> 1) & 7, fq = lane >> 4;
    P3_LOAD(wrA, xrA, 0); P3_LOAD(wrB, xrB, 1);
    P3_STORE(wrA, xrA, 0);
    __syncthreads();
    for (int kt = 0; kt < 32; kt += 2) {
        if (kt + 2 < 32) P3_LOAD(wrA, xrA, kt + 2);
        P3_COMPUTE(0);
        P3_STORE(wrB, xrB, 1);
        __syncthreads();
        if (kt + 3 < 32) P3_LOAD(wrB, xrB, kt + 3);
        P3_COMPUTE(1);
        if (kt + 2 < 32) P3_STORE(wrA, xrA, 0);
        __syncthreads();
    }
#undef P3_LOAD
#undef P3_STORE
#undef P3_COMPUTE
    char* hb = lds + half * 40960;
    char* Hs = hb;
    float* Os = (float*)(hb + 16384);
    {
        const int dq = (lane >> 4) * 4;
#pragma unroll
        for (int ni = 0; ni < 4; ++ni) { const int n = w * 64 + ni * 16 + dq; const f32x4 bv = *(const f32x4*)(bias1 + n);
#pragma unroll
            for (int mi = 0; mi < 2; ++mi) { const int m = mi * 16 + (lane & 15); const f32x4 a = acc[ni][mi] + bv;
                u32x2 o; o.x = pk2(a.x * sigm(a.x), a.y * sigm(a.y)); o.y = pk2(a.z * sigm(a.z), a.w * sigm(a.w));
                *(u32x2*)(Hs + m * 512 + (((n >> 3) ^ (m & 15)) << 4) + ((n >> 2) & 1) * 8) = o; } }
    }
    __syncthreads();
    {
        f32x4 a2[2] = {(f32x4){0.f, 0.f, 0.f, 0.f}, (f32x4){0.f, 0.f, 0.f, 0.f}};
        const bf16_t* w2p = W2 + (size_t)(w * 16 + (lane & 15)) * 256 + fq * 8;
#pragma unroll
        for (int ks = 0; ks < 8; ++ks) {
            const bf16x8 wf = *(const bf16x8*)(w2p + ks * 32);
#pragma unroll
            for (int mi = 0; mi < 2; ++mi) { const int m = mi * 16 + (lane & 15);
                const bf16x8 xf = *(const bf16x8*)(Hs + m * 512 + (((ks * 4 + fq) ^ (m & 15)) << 4));
                a2[mi] = mfma16(wf, xf, a2[mi]); }
        }
#pragma unroll
        for (int mi = 0; mi < 2; ++mi) *(f32x4*)(Os + (mi * 16 + (lane & 15)) * 68 + w * 16 + fq * 4) = a2[mi];
    }
    __syncthreads();
    {
        const int m = ht >> 3, d0 = (ht & 7) * 8;
        f32x4 v0 = *(const f32x4*)(Os + m * 68 + d0), v1 = *(const f32x4*)(Os + m * 68 + d0 + 4);
        if (kv == 0) {
            float ss = (v0.x * v0.x + v0.y * v0.y) + (v0.z * v0.z + v0.w * v0.w) + (v1.x * v1.x + v1.y * v1.y) + (v1.z * v1.z + v1.w * v1.w);
            ss += __shfl_xor(ss, 1); ss += __shfl_xor(ss, 2); ss += __shfl_xor(ss, 4);
            const float rs = rsq(ss * (1.f / 64.f) + EPS);
            v0 = v0 * rs * *(const f32x4*)(p.k_gain_cmp + d0); v1 = v1 * rs * *(const f32x4*)(p.k_gain_cmp + d0 + 4);
        }
        u32x4 o; o.x = pk2(v0.x, v0.y); o.y = pk2(v0.z, v0.w); o.z = pk2(v1.x, v1.y); o.w = pk2(v1.z, v1.w);
        *(u32x4*)((bf16_t*)(p.ws + (kv ? WS_VCMP : WS_KCMP)) + ((size_t)bg * 256 + ct * 32 + m) * 64 + d0) = o;
    }
    __syncthreads();
}
DI void phase3(const Params& p, char* lds) {
    for (int it = blockIdx.x; it < 256; it += gridDim.x) p3_pair(p, it, lds, threadIdx.x);
}

constexpr int L4_WSCR = 65536;
constexpr int L4_TBL0 = L4_WSCR + 8 * 8448;
constexpr int L4_TBL1 = L4_TBL0 + 7424;
constexpr int L4_SC = L4_TBL1 + 7424;
constexpr int L4_UNIT = L4_SC + 64;
static_assert(L4_UNIT + 16 <= LDS_MISC, "P4 LDS map");
struct WB { int hi_min, hi_max, lo_min, lo_max; };

template <int OFF> DI s16x4 tr_read(unsigned a) { s16x4 r; asm volatile("ds_read_b64_tr_b16 %0, %1 offset:%2" : "=&v"(r) : "v"(a), "i"(OFF) : "memory"); return r; }
#define TR_WAIT() do { asm volatile("s_waitcnt lgkmcnt(0)" ::: "memory"); __builtin_amdgcn_sched_barrier(0); } while (0)
#define PK8(L, H) (bf16x8){L[0], L[1], L[2], L[3], H[0], H[1], H[2], H[3]}
struct LaneC { int kA, vA0, vA1, Xc, h4; };
DI void pack_p(const f32x16& s, float& lsum, bf16x8 (&pf)[2]) {
    float e[16];
#pragma unroll
    for (int r = 0; r < 16; ++r) e[r] = ex2(s[r]);
    float t0 = (e[0] + e[1]) + (e[2] + e[3]), t1 = (e[4] + e[5]) + (e[6] + e[7]), t2 = (e[8] + e[9]) + (e[10] + e[11]), t3 = (e[12] + e[13]) + (e[14] + e[15]);
    lsum += (t0 + t1) + (t2 + t3);
#pragma unroll
    for (int s2 = 0; s2 < 2; ++s2) { u32x4 pp; pp.x = pk2(e[8 * s2 + 0], e[8 * s2 + 1]); pp.y = pk2(e[8 * s2 + 2], e[8 * s2 + 3]);
        pp.z = pk2(e[8 * s2 + 4], e[8 * s2 + 5]); pp.w = pk2(e[8 * s2 + 6], e[8 * s2 + 7]); pf[s2] = __builtin_bit_cast(bf16x8, pp); }
}
DI void subtile2_pv(const char* lds, int stoff  , int k0, const LaneC& lc, const bf16x8 (&qa)[4], const bf16x8 (&qb)[4],
                    f32x16 (&OA)[2], f32x16 (&OB)[2], float& lA, float& lB,
                    const f32x16& cin  , float tadd  , bool use_tbl, int tboffA, int tboffB,
                    bool need_hi, int hi_t, bool need_lo, int lo_t) {
    f32x16 sa, sb;
    bf16x8 kf[4];
#pragma unroll
    for (int ks = 0; ks < 4; ++ks) kf[ks] = *(const bf16x8*)(lds + stoff + (lc.kA ^ (ks << 5)));
    if (use_tbl) {
#pragma unroll
        for (int i = 0; i < 16; ++i) { sa[i] = 0.f; sb[i] = 0.f; }
    } else { sa = cin; sb = cin; }
    __builtin_amdgcn_s_setprio(1);
#pragma unroll
    for (int ks = 0; ks < 4; ++ks) { sa = mfma32(kf[ks], qa[ks], sa); sb = mfma32(kf[ks], qb[ks], sb); }
    __builtin_amdgcn_s_setprio(0);
    if (use_tbl) {
        const int X = lc.Xc + k0; const int to = (X & 1) * 928 + (X & ~1) * 4; const char* tpa = lds + tboffA + to; const char* tpb = lds + tboffB + to;
#pragma unroll
        for (int q = 0; q < 4; ++q) { const f32x2 t0 = *(const f32x2*)(tpa + 32 * q), t1 = *(const f32x2*)(tpa + 32 * q + 8);
            sa[4 * q] += t0.x + tadd; sa[4 * q + 1] += t0.y + tadd; sa[4 * q + 2] += t1.x + tadd; sa[4 * q + 3] += t1.y + tadd;
            const f32x2 u0 = *(const f32x2*)(tpb + 32 * q), u1 = *(const f32x2*)(tpb + 32 * q + 8);
            sb[4 * q] += u0.x + tadd; sb[4 * q + 1] += u0.y + tadd; sb[4 * q + 2] += u1.x + tadd; sb[4 * q + 3] += u1.y + tadd; }
    }
    if (need_hi) { const int H = hi_t - k0 - lc.h4;
#pragma unroll
        for (int r = 0; r < 16; ++r) { const bool ok = (r & 3) + 8 * (r >> 2) <= H; sa[r] = ok ? sa[r] : -INFINITY; sb[r] = ok ? sb[r] : -INFINITY; } }
    if (need_lo) { const int L = lo_t - k0 - lc.h4;
#pragma unroll
        for (int r = 0; r < 16; ++r) { const bool ok = (r & 3) + 8 * (r >> 2) >= L; sa[r] = ok ? sa[r] : -INFINITY; sb[r] = ok ? sb[r] : -INFINITY; } }
    const unsigned vb = (unsigned)(size_t)(LAS const char*)lds + (unsigned)(stoff + 8192);
    const unsigned va0 = vb + (unsigned)lc.vA0, va1 = vb + (unsigned)lc.vA1;
    const s16x4 a0 = tr_read<0>(va0), a1 = tr_read<1024>(va0), a2 = tr_read<2048>(va0), a3 = tr_read<3072>(va0);
    const s16x4 b0 = tr_read<0>(va1), b1 = tr_read<1024>(va1), b2 = tr_read<2048>(va1), b3 = tr_read<3072>(va1);
    bf16x8 pa[2], pb[2];
    pack_p(sa, lA, pa);
    TR_WAIT();
    __builtin_amdgcn_s_setprio(1);
    OA[0] = mfma32(PK8(a0, a1), pa[0], OA[0]); OA[1] = mfma32(PK8(b0, b1), pa[0], OA[1]);
    OA[0] = mfma32(PK8(a2, a3), pa[1], OA[0]); OA[1] = mfma32(PK8(b2, b3), pa[1], OA[1]);
    __builtin_amdgcn_s_setprio(0);
    __builtin_amdgcn_sched_barrier(0);
    pack_p(sb, lB, pb);
    __builtin_amdgcn_sched_barrier(0);
    __builtin_amdgcn_s_setprio(1);
    OB[0] = mfma32(PK8(a0, a1), pb[0], OB[0]); OB[1] = mfma32(PK8(b0, b1), pb[0], OB[1]);
    OB[0] = mfma32(PK8(a2, a3), pb[1], OB[0]); OB[1] = mfma32(PK8(b2, b3), pb[1], OB[1]);
    __builtin_amdgcn_s_setprio(0);
}

DI void load_q(const bf16_t* HM, int slot, int m, int lane, bf16x8 (&qf)[4]) {
    const bf16_t* q = HM + ((size_t)slot * M + m) * 64 + (lane >> 5) * 8;
#pragma unroll
    for (int ks = 0; ks < 4; ++ks) qf[ks] = *(const bf16x8*)(q + ks * 16);
}
DI void write_y2(bf16_t* Y, const bf16_t* HM, int zslotA, int zslotB, int m, int colA, int colB, int lane, const f32x16 (&ya)[2], const f32x16 (&yb)[2]) {
    const int h = lane >> 5;
    const bf16_t* za = HM + ((size_t)zslotA * M + m) * 64 + 4 * h; const bf16_t* zb = HM + ((size_t)zslotB * M + m) * 64 + 4 * h;
    u32x2 zza[8], zzb[8];
#pragma unroll
    for (int i = 0; i < 8; ++i) { zza[i] = *(const u32x2*)(za + 8 * i); zzb[i] = *(const u32x2*)(zb + 8 * i); }
    asm volatile("" ::: "memory");
    bf16_t* ypa = Y + (size_t)m * 1024 + colA + 4 * h; bf16_t* ypb = Y + (size_t)m * 1024 + colB + 4 * h;
#pragma unroll
    for (int i = 0; i < 8; ++i) { const int db = i >> 2, rg = i & 3;
        u32x2 o; o.x = pk2(ya[db][4 * rg + 0] * bflo(zza[i].x), ya[db][4 * rg + 1] * bfhi(zza[i].x));
        o.y = pk2(ya[db][4 * rg + 2] * bflo(zza[i].y), ya[db][4 * rg + 3] * bfhi(zza[i].y));
        *(u32x2*)(ypa + 8 * i) = o;
        u32x2 q; q.x = pk2(yb[db][4 * rg + 0] * bflo(zzb[i].x), yb[db][4 * rg + 1] * bfhi(zzb[i].x));
        q.y = pk2(yb[db][4 * rg + 2] * bflo(zzb[i].y), yb[db][4 * rg + 3] * bfhi(zzb[i].y));
        *(u32x2*)(ypb + 8 * i) = q; }
}
DI float table_far(const float* tbl, int r) { return tbl[r * 464 + 63]; }
DI f32x16 cmp_qk(const char* lds, int st, int lane, const bf16x8 (&qf)[4]) {
    f32x16 s;
#pragma unroll
    for (int i = 0; i < 16; ++i) s[i] = 0.f;
    const int row = st * 32 + (lane & 31), h = lane >> 5; const char* kp = lds + row * 128; const int sw = (row >> 1) & 7;
#pragma unroll
    for (int ks = 0; ks < 4; ++ks) { const bf16x8 kf = *(const bf16x8*)(kp + (((2 * ks + h) ^ sw) << 4)); s = mfma32(kf, qf[ks], s); }
    return s;
}

DI void unit(const Params& p, bool isB, int bg, int qb, char* lds) {
    int tid_ = threadIdx.x; asm volatile("" : "+v"(tid_));
    const int tid = tid_, lane = tid & 63, w = __builtin_amdgcn_readfirstlane(tid >> 6), b = bg >> 1, g = bg & 1, h = lane >> 5;
    const bf16_t* HM = (const bf16_t*)(p.ws + WS_HM); bf16_t* Y = (bf16_t*)(p.ws + WS_Y); const float* GB = (const float*)(p.ws + WS_GB);
    float* tbl0 = (float*)(lds + L4_TBL0); float* tbl1 = (float*)(lds + L4_TBL1); float* sc = (float*)(lds + L4_SC);
    float* wsc = (float*)(lds + L4_WSCR + w * 8448) + lane;
    const int t0 = isB ? qb * 256 : qb * 128, tq0 = t0 + 32 * (isB ? w : (w & 3)), tq = tq0 + (lane & 31), m = b * 4096 + tq;
    const int thi = (t0 + (isB ? 255 : 127)) >> 6;
    const bf16_t* Kc = (const bf16_t*)(p.ws + WS_KCMP) + (size_t)bg * 256 * 64;
    const bf16_t* Vc = (const bf16_t*)(p.ws + WS_VCMP) + (size_t)bg * 256 * 64;
    const int hic_t = (tq - 31) >> 4;
    const int ctmax = ((t0 + 224) >> 4) >> 6;
    const float* TG = (const float*)(p.ws + WS_TBL);
    const float ccmp = TG[3 * 8 * 464 + 24];
    unsigned mask_even = 0xffffffffu, mask_odd = 0xffffffffu;
    {
        const int k0_ = isB ? 1 : 0;
        if (tid < 464) { *(f32x4*)(tbl0 + 4 * tid) = *(const f32x4*)(TG + (k0_ * 8 + 4 * g) * 464 + 4 * tid);
            if (isB) *(f32x4*)(tbl1 + 4 * tid) = *(const f32x4*)(TG + (2 * 8 + 4 * g) * 464 + 4 * tid); }
        if (tid < 4) sc[tid] = TG[3 * 8 * 464 + k0_ * 8 + 4 * g + tid];
    }
    if (isB) {
        const int nst = ((tq0 >> 4) >> 5) + 1;
        for (int i = tid; i < (ctmax + 1) * 512; i += NTHREADS) { const int row = i >> 3, ch = i & 7;
            *(u32x4*)(lds + row * 128 + ((ch ^ ((row >> 1) & 7)) << 4)) = *(const u32x4*)(Kc + (size_t)i * 8); }
        for (int i = 0; i < 33; ++i) wsc[i * 64] = 0.f;
        __syncthreads();
        {
            const int hic_min = (tq0 - 31) >> 4;
            f32x16 cinc;
#pragma unroll
            for (int i = 0; i < 16; ++i) cinc[i] = ccmp;
#pragma unroll 1
            for (int r = 0; r < 4; ++r) {
                bf16x8 qf[4]; load_q(HM, 20 + 4 * g + r, m, lane, qf);
                float lsum = 0.f;
                float E[33];
#pragma unroll
                for (int i = 0; i < 33; ++i) E[i] = 0.f;
#pragma unroll
                for (int st = 0; st < 8; ++st) {
                    if (st < nst) {
                        f32x16 s = cinc;
                        { const int row = st * 32 + (lane & 31); const char* kp = lds + row * 128; const int sw = (row >> 1) & 7;
#pragma unroll
                          for (int ks = 0; ks < 4; ++ks) { const bf16x8 kf = *(const bf16x8*)(kp + (((2 * ks + h) ^ sw) << 4)); s = mfma32(kf, qf[ks], s); } }
                        if (st * 32 + 31 > hic_min) { const int H = hic_t - st * 32 - 4 * h;
#pragma unroll
                            for (int i = 0; i < 16; ++i) s[i] = ((i & 3) + 8 * (i >> 2) <= H) ? s[i] : -INFINITY; }
#pragma unroll
                        for (int q = 0; q < 4; ++q) {
                            const float e0 = ex2(s[4 * q]), e1 = ex2(s[4 * q + 1]), e2 = ex2(s[4 * q + 2]), e3 = ex2(s[4 * q + 3]);
                            lsum += (e0 + e1) + (e2 + e3);
                            const float half = 0.5f * e3;
                            const float recv = __shfl_xor(half, 32);
                            E[st * 4 + q] += (e0 + e1) + (e2 + half) + (h ? recv : 0.f);
                            E[st * 4 + q + 1] += (h ? 0.f : recv);
                        }
                    }
                }
                const float l = lsum + __shfl_xor(lsum, 32);
                const float inv = l > 0.f ? 1.f / l : 0.f;
#pragma unroll
                for (int i = 0; i < 33; ++i) wsc[i * 64] += E[i] * inv;
            }
        }
        const int cur = tq0 >> 6;
        if (cur >= 16) {
            unsigned* keyL = (unsigned*)wsc;
#pragma unroll 4
            for (int i = 0; i < 32; ++i) { const int j = 2 * i + h; const bool ok = (j >= 1) && (j <= cur - 2);
                const unsigned bits = __builtin_bit_cast(unsigned, wsc[i * 64]);
                keyL[i * 64] = ok ? ((bits & 0xffffffc0u) + 64u + (unsigned)(63 - j)) : 0u; }
            mask_even = 1u; mask_odd = 0u;
            if (cur & 1) { mask_odd |= 1u << (cur >> 1); mask_even |= 1u << ((cur - 1) >> 1); }
            else { mask_even |= 1u << (cur >> 1); mask_odd |= 1u << ((cur - 1) >> 1); }
#pragma unroll 1
            for (int it = 0; it < 13; ++it) {
                unsigned mx = 0u;
#pragma unroll 8
                for (int i = 0; i < 32; ++i) { const unsigned k = keyL[i * 64]; mx = mx > k ? mx : k; }
                const unsigned mo = (unsigned)__shfl_xor((int)mx, 32); mx = mx > mo ? mx : mo;
                const int j = 63 - (int)(mx & 63u);
                if ((j & 1) == h) keyL[(j >> 1) * 64] = 0u;
                if (j & 1) mask_odd |= 1u << (j >> 1); else mask_even |= 1u << (j >> 1);
            }
        }
    }
    __syncthreads();
    const int nbr = isB ? 3 : 1;
    int lo0, hi0, lo1 = 0, hi1 = 0, lo2 = 0, hi2 = 0;
    const bf16_t *Kb0, *Vb0, *Kb1 = nullptr, *Vb1 = nullptr, *Kb2 = nullptr, *Vb2 = nullptr;
    if (!isB) { lo0 = (t0 - 128) < 0 ? 0 : ((t0 - 128) >> 6); hi0 = thi;
        Kb0 = HM + ((size_t)(8 + g) * M + (size_t)b * 4096) * 64; Vb0 = HM + ((size_t)(10 + g) * M + (size_t)b * 4096) * 64; }
    else { lo0 = 0; hi0 = ctmax; lo1 = 0; hi1 = thi; lo2 = (t0 - 512) < 0 ? 0 : ((t0 - 512) >> 6); hi2 = thi;
        Kb0 = Kc; Vb0 = Vc;
        Kb1 = HM + ((size_t)(32 + g) * M + (size_t)b * 4096) * 64; Vb1 = HM + ((size_t)(34 + g) * M + (size_t)b * 4096) * 64;
        Kb2 = HM + ((size_t)(36 + g) * M + (size_t)b * 4096) * 64; Vb2 = HM + ((size_t)(38 + g) * M + (size_t)b * 4096) * 64; }
    int l_it = 0, l_br = 0, l_tile = lo0, k_issued = 0, kidx = 0;
    const int n_it = isB ? 2 * nbr : 1;
    const int drow = 8 * w + (lane >> 3), dpc = lane & 7;
    const int koff = drow * 64 + ((dpc ^ ((drow >> 1) & 7)) << 3);
    const int voff = drow * 64 + ((dpc ^ (((drow >> 1) & 1) << 2)) << 3);
    LaneC lc;
    { const int kr = lane & 31, i16 = lane & 15, q4 = i16 >> 2, p4 = i16 & 3, g16 = (lane >> 4) & 1, vsw = ((q4 >> 1) & 1) << 3, cb = 4 * g16 + p4;
      lc.kA = kr * 128 + ((h ^ ((kr >> 1) & 7)) << 4);
      lc.vA0 = (4 * h + q4) * 128 + ((cb ^ vsw) << 3); lc.vA1 = (4 * h + q4) * 128 + (((8 + cb) ^ vsw) << 3);
      lc.Xc = 191 - tq + 4 * h; lc.h4 = 4 * h; }
#define ISSUE_INTERVAL() do { if (l_it < n_it) { \
        const bf16_t* kb_ = l_br == 0 ? Kb0 : (l_br == 1 ? Kb1 : Kb2); const bf16_t* vb_ = l_br == 0 ? Vb0 : (l_br == 1 ? Vb1 : Vb2); \
        const int lhi_ = l_br == 0 ? hi0 : (l_br == 1 ? hi1 : hi2); \
        LAS unsigned* dst_ = (LAS unsigned*)(lds + (k_issued & 1) * 32768 + w * 1024); \
        __builtin_amdgcn_global_load_lds((const unsigned*)(kb_ + (size_t)l_tile * 4096 + koff), dst_, 16, 0, 0); \
        __builtin_amdgcn_global_load_lds((const unsigned*)(vb_ + (size_t)l_tile * 4096 + voff), dst_ + 2048, 16, 0, 0); \
        if (l_tile < lhi_) { \
            __builtin_amdgcn_global_load_lds((const unsigned*)(kb_ + (size_t)(l_tile + 1) * 4096 + koff), dst_ + 4096, 16, 0, 0); \
            __builtin_amdgcn_global_load_lds((const unsigned*)(vb_ + (size_t)(l_tile + 1) * 4096 + voff), dst_ + 6144, 16, 0, 0); } \
        l_tile += 2; \
        if (l_tile > lhi_) { ++l_it; l_br = (l_br + 1 == nbr) ? 0 : l_br + 1; l_tile = l_br == 0 ? lo0 : (l_br == 1 ? lo1 : lo2); } } \
        ++k_issued; } while (0)
    ISSUE_INTERVAL();
    bf16x8 qfa[4], qfb[4];
    unsigned* wpk = (unsigned*)wsc;
#pragma unroll 1
    for (int it = 0; it < n_it; ++it) {
        const int hp = isB ? it / 3 : (w >> 2), br = isB ? it - 3 * hp : 0, rA = 2 * hp, rB = 2 * hp + 1;
        const int mode = isB ? br + 1 : 0;
        if (br == 0) { load_q(HM, (isB ? 20 : 0) + 4 * g + rA, m, lane, qfa); load_q(HM, (isB ? 20 : 0) + 4 * g + rB, m, lane, qfb); }
        const int tlo = __builtin_amdgcn_readfirstlane(br == 0 ? lo0 : (br == 1 ? lo1 : lo2)), th = __builtin_amdgcn_readfirstlane(br == 0 ? hi0 : (br == 1 ? hi1 : hi2));
        int hi_t = tq, lo_t = 0; bool bias = true, sel = false, scaled = true;
        int tboffA = L4_TBL0 + rA * 1856, tboffB = L4_TBL0 + rB * 1856; WB wb; wb.hi_min = tq0; wb.hi_max = tq0 + 31; wb.lo_min = 0; wb.lo_max = 0;
        float gateA = 1.f, gateB = 1.f, ccom = 0.f, fA = 1.f, fB = 1.f;
        if (mode == 0) { lo_t = tq - 127; wb.lo_min = tq0 - 127; wb.lo_max = tq0 + 31 - 127; }
        else if (mode == 1) { hi_t = hic_t; bias = false; wb.hi_min = (tq0 - 31) >> 4; wb.hi_max = tq0 >> 4; ccom = ccmp; }
        else if (mode == 2) { sel = true; scaled = false; ccom = TG[3 * 8 * 464 + 25 + 1]; fA = ex2(table_far(tbl0, rA) - ccom); fB = ex2(table_far(tbl0, rB) - ccom); }
        else { tboffA = L4_TBL1 + rA * 1856; tboffB = L4_TBL1 + rB * 1856; scaled = false; ccom = TG[3 * 8 * 464 + 25 + 2];
            fA = ex2(table_far(tbl1, rA) - ccom); fB = ex2(table_far(tbl1, rB) - ccom);
            lo_t = tq - 511; wb.lo_min = tq0 - 511; wb.lo_max = tq0 + 31 - 511; }
        if (isB) { gateA = GB[(size_t)m * 24 + (4 * g + rA) * 3 + br]; gateB = GB[(size_t)m * 24 + (4 * g + rB) * 3 + br]; }
        f32x16 OA[2], OB[2], cin;
#pragma unroll
        for (int i = 0; i < 16; ++i) { OA[0][i] = 0.f; OA[1][i] = 0.f; OB[0][i] = 0.f; OB[1][i] = 0.f; cin[i] = ccom; }
        float lA = 0.f, lB = 0.f;
#pragma unroll 1
        for (int tile0 = tlo; tile0 <= th; tile0 += 2) {
            asm volatile("s_waitcnt vmcnt(0)" ::: "memory");
            __builtin_amdgcn_s_barrier();
            asm volatile("" ::: "memory");
            ISSUE_INTERVAL();
            const int sbase = (kidx & 1) * 32768;
            ++kidx;
#pragma unroll 1
            for (int tt = 0; tt < 2; ++tt) {
                const int tile = tile0 + tt;
                if (tile > th) break;
                const int stoff = sbase + tt * 16384;
                float selterm = 0.f; bool any = true;
                if (sel) { const unsigned mk = (tile & 1) ? mask_odd : mask_even; const bool bit = (mk >> (tile >> 1)) & 1u;
                    selterm = bit ? 0.f : -INFINITY; any = __ballot(bit) != 0ull;
                    if (any) { const float cv = bit ? ccom : -INFINITY;
#pragma unroll
                        for (int i = 0; i < 16; ++i) cin[i] = cv; } }
                if (any) {
#pragma unroll
                    for (int sub = 0; sub < 2; ++sub) {
                        const int k0 = tile * 64 + sub * 32;
                        if (k0 > wb.hi_max || k0 + 31 < wb.lo_min) continue;
                        const bool need_hi = k0 + 31 > wb.hi_min, need_lo = k0 < wb.lo_max;
                        const bool use_tbl = bias && (tq0 - (k0 + 31) < 128);
                        if (use_tbl && !scaled) {
                            scaled = true;
#pragma unroll
                            for (int i = 0; i < 16; ++i) { OA[0][i] *= fA; OA[1][i] *= fA; OB[0][i] *= fB; OB[1][i] *= fB; }
                            lA *= fA; lB *= fB; }
                        subtile2_pv(lds, stoff + sub * 4096, k0, lc, qfa, qfb, OA, OB, lA, lB, cin, selterm, use_tbl, tboffA, tboffB, need_hi, hi_t, need_lo, lo_t);
                    }
                }
            }
        }
        if (!scaled) { lA *= fA; lB *= fB;
#pragma unroll
            for (int i = 0; i < 16; ++i) { OA[0][i] *= fA; OA[1][i] *= fA; OB[0][i] *= fB; OB[1][i] *= fB; } }
        float la = lA + __shfl_xor(lA, 32), lb = lB + __shfl_xor(lB, 32);
        if (mode == 0) { la += ex2((p.sinks[4 * g + rA] - sc[rA]) * LOG2E); lb += ex2((p.sinks[4 * g + rB] - sc[rB]) * LOG2E); }
        const float sa_ = (la > 0.f ? 1.f / la : 0.f) * gateA, sb_ = (lb > 0.f ? 1.f / lb : 0.f) * gateB;
#pragma unroll
        for (int i = 0; i < 16; ++i) { OA[0][i] *= sa_; OA[1][i] *= sa_; OB[0][i] *= sb_; OB[1][i] *= sb_; }
        if (br != 0) {
#pragma unroll
            for (int i = 0; i < 8; ++i) { const unsigned u0 = wpk[i * 64], u1 = wpk[(8 + i) * 64], v0 = wpk[(16 + i) * 64], v1 = wpk[(24 + i) * 64];
                OA[0][2 * i] += bflo(u0); OA[0][2 * i + 1] += bfhi(u0); OA[1][2 * i] += bflo(u1); OA[1][2 * i + 1] += bfhi(u1);
                OB[0][2 * i] += bflo(v0); OB[0][2 * i + 1] += bfhi(v0); OB[1][2 * i] += bflo(v1); OB[1][2 * i + 1] += bfhi(v1); }
        }
        if (br == nbr - 1) {
            write_y2(Y, HM, (isB ? 40 : 12) + 4 * g + rA, (isB ? 40 : 12) + 4 * g + rB, m, (isB ? 512 : 0) + (4 * g + rA) * 64, (isB ? 512 : 0) + (4 * g + rB) * 64, lane, OA, OB);
        } else {
#pragma unroll
            for (int i = 0; i < 8; ++i) { wpk[i * 64] = pk2(OA[0][2 * i], OA[0][2 * i + 1]); wpk[(8 + i) * 64] = pk2(OA[1][2 * i], OA[1][2 * i + 1]);
                wpk[(16 + i) * 64] = pk2(OB[0][2 * i], OB[0][2 * i + 1]); wpk[(24 + i) * 64] = pk2(OB[1][2 * i], OB[1][2 * i + 1]); }
        }
    }
#undef ISSUE_INTERVAL
    asm volatile("s_waitcnt vmcnt(0)" ::: "memory");
    __syncthreads();
}

DI void phase4(const Params& p, char* lds) {
    unsigned* ctr = (unsigned*)(p.ws + WS_CTL);
    volatile int* su = (volatile int*)(lds + L4_UNIT);
    for (;;) {
        if (threadIdx.x == 0) *su = (int)atomicAdd(ctr, 1u);
        __syncthreads();
        const int u = __builtin_amdgcn_readfirstlane(*su);
        __syncthreads();
        if (u >= 1536) break;
        const bool isB = u < 512; const int uu = isB ? u : u - 512;
        unit(p, isB, uu & 31, (isB ? 15 : 31) - (uu >> 5), lds);
    }
}

__global__ void __launch_bounds__(NTHREADS, 2) fwd_kernel(Params p) {
    extern __shared__ __attribute__((aligned(16))) char lds[];
    const int lo = p.ph_lo, hi = p.ph_hi;
    volatile LAS unsigned* misc = (volatile LAS unsigned*)(LAS char*)(lds + LDS_MISC);
    if (threadIdx.x < 16) misc[threadIdx.x] = 0u;
    __syncthreads();
    XcdBarrier bar = xcd_barrier_post((unsigned*)(p.ws + WS_CTL) + 1024, misc);
#define IN(k) (lo <= (k) && (k) < hi)
#define SEAM(k) do { if (IN((k) + 1)) xcd_barrier(bar); } while (0)
    if (IN(0)) { phase0(p, lds); SEAM(0); }
    if (IN(1)) { phase1(p, lds); SEAM(1); }
    if (IN(2)) {
        pg8::Gemm gm{(const bf16_t*)(p.ws + WS_H), (const bf16_t*)(p.ws + WS_WINT), M, NPADW, 1024};
        pg8::StaticOrder S; S.init(M, NPADW, (int)gridDim.x, (int)blockIdx.x);
        EpiIn E{(bf16_t*)(p.ws + WS_HM), (float*)(p.ws + WS_GB), p.q_gain_a, p.k_gain_a, p.q_gain_b, p.k_gain_sel, p.k_gain_win, p.b_gate};
        pg8::gemm_phase<EpiIn, pg8::StaticOrder, GEMM_ALIGN, GEMM_SP2>((LAS unsigned char*)lds, gm, S, E);
        SEAM(2);
    }
    if (IN(3)) { phase3(p, lds); SEAM(3); }
    if (IN(4)) { phase4(p, lds); SEAM(4); }
    if (IN(5)) {
        pg8::Gemm gm{(const bf16_t*)(p.ws + WS_Y), (const bf16_t*)(p.ws + WS_WOUTT), M, 1024, 1024};
        pg8::StaticOrder S; S.init(M, 1024, (int)gridDim.x, (int)blockIdx.x);
        EpiOut E{p.x, (const float*)(p.ws + WS_MOD), p.out};
        pg8::gemm_phase<EpiOut, pg8::StaticOrder, GEMM_ALIGN, GEMM_SP2>((LAS unsigned char*)lds, gm, S, E);
    }
#undef IN
#undef SEAM
}

extern "C" void kernel_launch(void* const* d_in, const int* in_sizes, int n_in, void* d_out, int out_size, void* d_ws, size_t ws_size, hipStream_t stream) {
    static int grid = 0;
    if (grid == 0) {
        if (n_in != 22 || out_size != M * DM || ws_size < WS_END) { fprintf(stderr, "kernel_launch: unexpected shapes (n_in %d out %d ws %zu need %zu)\n", n_in, out_size, ws_size, (size_t)WS_END); grid = -1; return; }
        int dev = 0, cus = 0, per_cu = 0;
        (void)hipGetDevice(&dev); (void)hipDeviceGetAttribute(&cus, hipDeviceAttributeMultiprocessorCount, dev);
        (void)hipFuncSetAttribute((const void*)fwd_kernel, hipFuncAttributeMaxDynamicSharedMemorySize, LDS_BYTES);
        (void)hipOccupancyMaxActiveBlocksPerMultiprocessor(&per_cu, (const void*)fwd_kernel, NTHREADS, LDS_BYTES);
        if (per_cu < 1) { fprintf(stderr, "kernel_launch: occupancy query says %d blocks/CU\n", per_cu); grid = -1; return; }
        grid = cus;
        fprintf(stderr, "kernel_launch: cus %d per_cu %d grid %d\n", cus, per_cu, grid);
    }
    if (grid < 0) return;
    (void)hipMemsetAsync((char*)d_ws + WS_CTL, 0, CTL_BYTES, stream);
    Params p{};
    const float** pin = (const float**)&p;
    for (int i = 0; i < 22; ++i) pin[i] = (const float*)d_in[i];
    p.out = (float*)d_out; p.ws = (unsigned char*)d_ws;
#if N_LAUNCHES == 1
    p.ph_lo = 0; p.ph_hi = 6;
    void* args[] = {&p};
    hipError_t e = hipLaunchCooperativeKernel((const void*)fwd_kernel, dim3(grid), dim3(NTHREADS), args, LDS_BYTES, stream);
    if (e != hipSuccess) fprintf(stderr, "cooperative launch failed: %s (grid %d)\n", hipGetErrorString(e), grid);
#else
    for (int ph = 0; ph < 6; ++ph) { p.ph_lo = ph; p.ph_hi = ph + 1; hipLaunchKernelGGL(fwd_kernel, dim3(grid), dim3(NTHREADS), LDS_BYTES, stream, p); }
#endif
}
```
